# Optimizing an MI355X kernel written in HIP

```python
import jax, jax.numpy as jnp
from jax import lax
import numpy as np

D_MODEL = 1024
BATCH = 4
SEQ = 4096
DEPTH = 2

HEAD_DIM = 64
N_Q_HEADS = 8
N_KV_HEADS = 2
Q_PER_KV = N_Q_HEADS // N_KV_HEADS
ATTN_WIDTH = N_Q_HEADS * HEAD_DIM
KV_WIDTH = N_KV_HEADS * HEAD_DIM
WINDOW = 128
ATTN_BLOCK = 128
ROPE_DIM = HEAD_DIM // 4
ROPE_THETA = 500000.0
N_SG_GROUPS = 8
SG_GROUP_DIM = 64
SG_WIDTH = N_SG_GROUPS * SG_GROUP_DIM
SG_CHUNK = 128
EVEN_GATE_WIDTH = ATTN_WIDTH + SG_WIDTH
EVEN_SPLITS = tuple(int(s) for s in np.cumsum([ATTN_WIDTH, KV_WIDTH, KV_WIDTH, SG_WIDTH, SG_WIDTH]))
EVEN_IN_WIDTH = EVEN_SPLITS[-1] + EVEN_GATE_WIDTH
RNN_WIDTH = D_MODEL
RNN_HEADS = 8
RNN_HEAD_DIM = RNN_WIDTH // RNN_HEADS
CONV_WIDTH = 4
CONV_PAD = (2, 1)
RG_LRU_C = 8.0
ODD_IN_WIDTH = 2 * RNN_WIDTH
N_EVEN = (DEPTH + 1) // 2
N_ODD = DEPTH // 2
DEEPNORM_ALPHA = (2 * DEPTH) ** 0.25
DEEPNORM_BETA = (8 * DEPTH) ** -0.25
LN_EPS = 1e-5
NEG_INF = -1e30

kernel_name = "hybrid_swa_gmlp_rglru_deepnorm_encoder"


def layer_norm(x, g, b):
    xf = x.astype(jnp.float32)
    mu = xf.mean(-1, keepdims=True)
    var = jnp.square(xf - mu).mean(-1, keepdims=True)
    y = (xf - mu) * lax.rsqrt(var + LN_EPS)
    return (y * g.astype(jnp.float32) + b.astype(jnp.float32)).astype(x.dtype)


def partial_rotary(t, positions):
    half = ROPE_DIM // 2
    inv_freq = jnp.power(jnp.float32(ROPE_THETA), -jnp.arange(half, dtype=jnp.float32) / half)
    ang = positions.astype(jnp.float32)[:, :, None, None] * inv_freq
    cos, sin = jnp.cos(ang), jnp.sin(ang)
    tr = t[..., :ROPE_DIM].astype(jnp.float32)
    t1, t2 = tr[..., :half], tr[..., half:]
    rot = jnp.concatenate([t1 * cos - t2 * sin, t2 * cos + t1 * sin], axis=-1)
    return jnp.concatenate([rot.astype(t.dtype), t[..., ROPE_DIM:]], axis=-1)


def windowed_gqa_sink(q, k, v, sink):
    B, S = q.shape[0], q.shape[1]
    nb = S // ATTN_BLOCK
    qb = q.reshape(B, nb, ATTN_BLOCK, N_KV_HEADS, Q_PER_KV, HEAD_DIM)

    def band(t):
        tp = jnp.pad(t, ((0, 0), (ATTN_BLOCK, ATTN_BLOCK), (0, 0), (0, 0)))
        parts = [tp[:, o * ATTN_BLOCK:o * ATTN_BLOCK + S].reshape(B, nb, ATTN_BLOCK, N_KV_HEADS, HEAD_DIM)
                 for o in range(3)]
        return jnp.concatenate(parts, axis=2)

    kb, vb = band(k), band(v)
    s = jnp.einsum('bnqhgd,bnkhd->bnhgqk', qb, kb).astype(jnp.float32) * (HEAD_DIM ** -0.5)
    qi = jnp.arange(ATTN_BLOCK)[:, None]
    kj = jnp.arange(3 * ATTN_BLOCK)[None, :]
    blk = jnp.arange(nb)[:, None, None]
    k_abs = blk * ATTN_BLOCK - ATTN_BLOCK + kj
    valid = (jnp.abs(kj - ATTN_BLOCK - qi) <= WINDOW) & (k_abs >= 0) & (k_abs < S)
    s = jnp.where(valid[None, :, None, None], s, NEG_INF)
    sink_l = sink.astype(jnp.float32).reshape(N_KV_HEADS, Q_PER_KV)[None, None, :, :, None, None]
    m = jnp.maximum(s.max(-1, keepdims=True), sink_l)
    p = jnp.exp(s - m)
    denom = p.sum(-1, keepdims=True) + jnp.exp(sink_l - m)
    o = jnp.einsum('bnhgqk,bnkhd->bnqhgd', (p / denom).astype(v.dtype), vb)
    return o.reshape(B, S, ATTN_WIDTH)


def chunked_spatial_gating(u, v, ln_g, ln_b, w_s, b_s):
    B, S = u.shape[0], u.shape[1]
    nc = S // SG_CHUNK
    vg = v.reshape(B, S, N_SG_GROUPS, SG_GROUP_DIM)
    vg = layer_norm(vg, ln_g.reshape(N_SG_GROUPS, SG_GROUP_DIM), ln_b.reshape(N_SG_GROUPS, SG_GROUP_DIM))
    vc = vg.reshape(B, nc, SG_CHUNK, N_SG_GROUPS, SG_GROUP_DIM)
    sv = jnp.einsum('gpq,bcqgd->bcpgd', w_s, vc) + b_s.T[None, None, :, :, None]
    return u * sv.reshape(B, S, SG_WIDTH)


def centred_depthwise_conv(x, w, b):
    y = lax.conv_general_dilated(x, w[:, None, :], window_strides=(1,), padding=[CONV_PAD],
                                 dimension_numbers=('NWC', 'WIO', 'NWC'),
                                 feature_group_count=x.shape[-1])
    return y + b


def rg_lru(x, w_a, b_a, w_x, b_x, lam, reverse):
    B, S = x.shape[0], x.shape[1]
    xh = x.reshape(B, S, RNN_HEADS, RNN_HEAD_DIM)
    pre_r = jnp.einsum('bshi,hij->bshj', xh, w_a).reshape(B, S, RNN_WIDTH) + b_a
    pre_i = jnp.einsum('bshi,hij->bshj', xh, w_x).reshape(B, S, RNN_WIDTH) + b_x
    rec_gate = jax.nn.sigmoid(pre_r.astype(jnp.float32))
    in_gate = jax.nn.sigmoid(pre_i.astype(jnp.float32))
    log_a = -RG_LRU_C * rec_gate * jax.nn.softplus(-lam.astype(jnp.float32))
    a = jnp.exp(log_a)
    bterm = jnp.sqrt(-jnp.expm1(2.0 * log_a)) * in_gate * x.astype(jnp.float32)

    def combine(lhs, rhs):
        a1, b1 = lhs
        a2, b2 = rhs
        return a1 * a2, a2 * b1 + b2

    _, h = lax.associative_scan(combine, (a, bterm), axis=1, reverse=reverse)
    return h


def even_mixer(h, positions, w_in, w_out, sink, sg_ln_g, sg_ln_b, sg_w, sg_b):
    B, S = h.shape[0], h.shape[1]
    q, k, v, su, sv, g = jnp.split(h @ w_in, EVEN_SPLITS, axis=-1)
    q = partial_rotary(q.reshape(B, S, N_Q_HEADS, HEAD_DIM), positions)
    k = partial_rotary(k.reshape(B, S, N_KV_HEADS, HEAD_DIM), positions)
    v = v.reshape(B, S, N_KV_HEADS, HEAD_DIM)
    y_attn = windowed_gqa_sink(q, k, v, sink)
    y_sg = chunked_spatial_gating(su, sv, sg_ln_g, sg_ln_b, sg_w, sg_b)
    y = jnp.concatenate([y_attn, y_sg], axis=-1) * jax.nn.silu(g)
    return y @ w_out


def odd_mixer(h, w_in, conv_w, conv_b, w_a, b_a, w_x, b_x, lam, w_out):
    xr, g = jnp.split(h @ w_in, 2, axis=-1)
    xr = centred_depthwise_conv(xr, conv_w, conv_b)
    y = (rg_lru(xr, w_a[0], b_a[0], w_x[0], b_x[0], lam[0], reverse=False)
         + rg_lru(xr, w_a[1], b_a[1], w_x[1], b_x[1], lam[1], reverse=True))
    y = y.astype(h.dtype) * jax.nn.silu(g)
    return y @ w_out


def setup_inputs(seed: int = 0) -> dict:
    key = jax.random.key(seed)
    ks = jax.random.split(key, 24)
    f32 = jnp.float32
    nrm = lambda k, shape, s: jax.random.normal(k, shape, f32) * s
    a_c = jax.random.uniform(ks[22], (N_ODD, 2, RNN_WIDTH), f32, minval=0.9, maxval=0.999)
    p = a_c ** (1.0 / RG_LRU_C)
    lam = jnp.log(p) - jnp.log1p(-p)
    return {
        "x": nrm(ks[0], (BATCH, SEQ, D_MODEL), 1.0),
        "c": nrm(ks[1], (BATCH, D_MODEL), 1.0),
        "positions": jnp.broadcast_to(jnp.arange(SEQ, dtype=jnp.int32), (BATCH, SEQ)),
        "ada_w": nrm(ks[2], (DEPTH, D_MODEL, 3 * D_MODEL), D_MODEL ** -0.5),
        "ada_b": nrm(ks[3], (DEPTH, 3 * D_MODEL), 0.01),
        "ln_g": 1.0 + nrm(ks[4], (DEPTH, D_MODEL), 0.02),
        "ln_b": nrm(ks[5], (DEPTH, D_MODEL), 0.02),
        "ev_w_in": nrm(ks[6], (N_EVEN, D_MODEL, EVEN_IN_WIDTH), D_MODEL ** -0.5),
        "ev_w_out": nrm(ks[7], (N_EVEN, EVEN_GATE_WIDTH, D_MODEL), DEEPNORM_BETA * EVEN_GATE_WIDTH ** -0.5),
        "ev_sink": nrm(ks[8], (N_EVEN, N_Q_HEADS), 1.0),
        "ev_sg_ln_g": 1.0 + nrm(ks[9], (N_EVEN, SG_WIDTH), 0.02),
        "ev_sg_ln_b": nrm(ks[10], (N_EVEN, SG_WIDTH), 0.02),
        "ev_sg_w": nrm(ks[11], (N_EVEN, N_SG_GROUPS, SG_CHUNK, SG_CHUNK), SG_CHUNK ** -0.5),
        "ev_sg_b": 1.0 + nrm(ks[12], (N_EVEN, N_SG_GROUPS, SG_CHUNK), 0.1),
        "od_w_in": nrm(ks[13], (N_ODD, D_MODEL, ODD_IN_WIDTH), D_MODEL ** -0.5),
        "od_conv_w": nrm(ks[14], (N_ODD, CONV_WIDTH, RNN_WIDTH), CONV_WIDTH ** -0.5),
        "od_conv_b": nrm(ks[15], (N_ODD, RNN_WIDTH), 0.01),
        "od_w_a": nrm(ks[16], (N_ODD, 2, RNN_HEADS, RNN_HEAD_DIM, RNN_HEAD_DIM), RNN_HEAD_DIM ** -0.5),
        "od_b_a": nrm(ks[17], (N_ODD, 2, RNN_WIDTH), 0.01),
        "od_w_x": nrm(ks[18], (N_ODD, 2, RNN_HEADS, RNN_HEAD_DIM, RNN_HEAD_DIM), RNN_HEAD_DIM ** -0.5),
        "od_b_x": nrm(ks[19], (N_ODD, 2, RNN_WIDTH), 0.01),
        "od_lam": lam,
        "od_w_out": nrm(ks[20], (N_ODD, RNN_WIDTH, D_MODEL), DEEPNORM_BETA * RNN_WIDTH ** -0.5),
    }


def reference(x, c, positions, ada_w, ada_b, ln_g, ln_b, ev_w_in, ev_w_out, ev_sink, ev_sg_ln_g, ev_sg_ln_b,
              ev_sg_w, ev_sg_b, od_w_in, od_conv_w, od_conv_b, od_w_a, od_b_a, od_w_x, od_b_x, od_lam, od_w_out):
    cond = jax.nn.silu(c)
    for layer in range(DEPTH):
        mod = cond @ ada_w[layer] + ada_b[layer]
        shift, scale, gate = jnp.split(mod, 3, axis=-1)
        h = x * (1.0 + scale[:, None, :]) + shift[:, None, :]
        j = layer // 2
        if layer % 2 == 0:
            y = even_mixer(h, positions, ev_w_in[j], ev_w_out[j], ev_sink[j], ev_sg_ln_g[j], ev_sg_ln_b[j],
                           ev_sg_w[j], ev_sg_b[j])
        else:
            y = odd_mixer(h, od_w_in[j], od_conv_w[j], od_conv_b[j], od_w_a[j], od_b_a[j], od_w_x[j],
                          od_b_x[j], od_lam[j], od_w_out[j])
        x = layer_norm(DEEPNORM_ALPHA * x + gate[:, None, :] * y, ln_g[layer], ln_b[layer])
    return x
```

```cpp
#include <hip/hip_runtime.h>
#include <hip/hip_cooperative_groups.h>
#include <cstdio>
namespace cg = cooperative_groups;

#define LAS __attribute__((address_space(3)))
typedef unsigned short bf16_t;
typedef short bf16x8 __attribute__((ext_vector_type(8)));
typedef short bf16x4 __attribute__((ext_vector_type(4)));
typedef float f32x4 __attribute__((ext_vector_type(4)));
typedef unsigned u32x4 __attribute__((ext_vector_type(4)));
typedef unsigned u32x2 __attribute__((ext_vector_type(2)));

constexpr int TOK = 16384, DM = 1024, SEQ = 4096;
constexpr int EW = 2816;
constexpr int OW = 2048;
constexpr float ALPHA = 1.41421356237f;

constexpr size_t OFF_WINT = 0;
constexpr size_t OFF_WOUTT = OFF_WINT + (size_t)2816 * 1024 * 2;
constexpr size_t OFF_OWINT = OFF_WOUTT + (size_t)1024 * 1024 * 2;
constexpr size_t OFF_OWOUTT = OFF_OWINT + (size_t)2048 * 1024 * 2;
constexpr size_t OFF_WAT = OFF_OWOUTT + (size_t)1024 * 1024 * 2;
constexpr size_t OFF_WXT = OFF_WAT + (size_t)16 * 128 * 128 * 2;
constexpr size_t OFF_SGW = OFF_WXT + (size_t)16 * 128 * 128 * 2;
constexpr size_t OFF_MOD = OFF_SGW + (size_t)8 * 128 * 128 * 2;
constexpr size_t OFF_SUM = OFF_MOD + (size_t)2 * 4 * 3072 * 4;
constexpr size_t SUM_SZ = (size_t)4 * 32 * 1024 * 4;
constexpr size_t OFF_H = OFF_SUM + 4 * SUM_SZ;
constexpr size_t OFF_PROJ = OFF_H + (size_t)TOK * 1024 * 2;
constexpr size_t OFF_Y = OFF_PROJ + (size_t)TOK * 2816 * 2;
constexpr size_t OFF_Z = OFF_Y + (size_t)TOK * 1024 * 2;
constexpr size_t OFF_BAR = OFF_Z + (size_t)TOK * 1024 * 4;
constexpr size_t WS_END = OFF_BAR + 256;

constexpr int LDS_BYTES = 131072;

struct Params {
    const float* x; const float* c; const int* pos; const float* ada_w; const float* ada_b; const float* ln_g; const float* ln_b;
    const float* ev_w_in; const float* ev_w_out; const float* ev_sink; const float* sg_ln_g; const float* sg_ln_b; const float* sg_w; const float* sg_b;
    const float* od_w_in; const float* conv_w; const float* conv_b; const float* w_a; const float* b_a; const float* w_x; const float* b_x; const float* lam; const float* od_w_out;
    float* out; unsigned char* ws;
};

__device__ __forceinline__ bf16_t f2bf(float f) { unsigned u = __float_as_uint(f); u += 0x7fffu + ((u >> 16) & 1u); return (bf16_t)(u >> 16); }
__device__ __forceinline__ float bf2f(bf16_t h) { return __uint_as_float(((unsigned)h) << 16); }
__device__ __forceinline__ unsigned pack2(float lo, float hi) { return (unsigned)f2bf(lo) | ((unsigned)f2bf(hi) << 16); }
__device__ __forceinline__ float lo2f(unsigned u) { return __uint_as_float(u << 16); }
__device__ __forceinline__ float hi2f(unsigned u) { return __uint_as_float(u & 0xffff0000u); }
__device__ __forceinline__ float silu_f(float v) { return v / (1.f + __expf(-v)); }
__device__ __forceinline__ int tid_fresh() { int t = threadIdx.x; asm volatile("" : "+v"(t)); return t; }
__device__ __forceinline__ float sigmoid_f(float v) { return 1.f / (1.f + __expf(-v)); }

__device__ void transpose_tile(const float* __restrict__ src, int src_ld, bf16_t* __restrict__ dst, int dst_ld, int k0, int n0, float* tile) {
    const int tid = tid_fresh();
#pragma unroll
    for (int e = 0; e < 8; ++e) { int idx = tid + e * 512; int r = idx >> 6, cc = idx & 63; tile[r * 65 + cc] = src[(size_t)(k0 + r) * src_ld + n0 + cc]; }
    __syncthreads();
#pragma unroll
    for (int e = 0; e < 8; ++e) { int idx = tid + e * 512; int n = idx >> 6, k = idx & 63; dst[(size_t)(n0 + n) * dst_ld + k0 + k] = f2bf(tile[k * 65 + n]); }
    __syncthreads();
}

__device__ void phase0(const Params& p, unsigned char* smem) {
    const int tid = tid_fresh();
    float* fs = (float*)smem;
    constexpr int J_MOD = 96, J0 = J_MOD, J1 = J0 + 704, J2 = J1 + 256, J3 = J2 + 512, J4 = J3 + 256, J5 = J4 + 64, J6 = J5 + 64, JEND = J6 + 32;
    for (int it = blockIdx.x; it < JEND; it += gridDim.x) {
        if (it < J_MOD) {
            float* sc = fs; float* red = fs + 4096;
            for (int i = tid; i < 4096; i += 512) { float v = p.c[i]; sc[i] = silu_f(v); }
            __syncthreads();
            const int l = it / 48, n0 = (it % 48) * 64, w = tid >> 6, lane = tid & 63;
            const float* W = p.ada_w + (size_t)l * 1024 * 3072 + n0 + lane;
            float a0 = 0.f, a1 = 0.f, a2 = 0.f, a3 = 0.f;
            for (int k = w * 128; k < w * 128 + 128; ++k) { float wv = W[(size_t)k * 3072]; a0 += sc[k] * wv; a1 += sc[1024 + k] * wv; a2 += sc[2048 + k] * wv; a3 += sc[3072 + k] * wv; }
            red[(w * 4 + 0) * 64 + lane] = a0; red[(w * 4 + 1) * 64 + lane] = a1; red[(w * 4 + 2) * 64 + lane] = a2; red[(w * 4 + 3) * 64 + lane] = a3;
            __syncthreads();
            if (tid < 256) { int b = tid >> 6; float s = 0.f; for (int w2 = 0; w2 < 8; ++w2) s += red[(w2 * 4 + b) * 64 + lane];
                ((float*)(p.ws + OFF_MOD))[(l * 4 + b) * 3072 + n0 + lane] = s + p.ada_b[l * 3072 + n0 + lane]; }
            __syncthreads();
        } else if (it < J1) { int j = it - J0; transpose_tile(p.ev_w_in, 2816, (bf16_t*)(p.ws + OFF_WINT), 1024, (j / 44) * 64, (j % 44) * 64, fs); }
        else if (it < J2) { int j = it - J1; transpose_tile(p.ev_w_out, 1024, (bf16_t*)(p.ws + OFF_WOUTT), 1024, (j / 16) * 64, (j % 16) * 64, fs); }
        else if (it < J3) { int j = it - J2; transpose_tile(p.od_w_in, 2048, (bf16_t*)(p.ws + OFF_OWINT), 1024, (j / 32) * 64, (j % 32) * 64, fs); }
        else if (it < J4) { int j = it - J3; transpose_tile(p.od_w_out, 1024, (bf16_t*)(p.ws + OFF_OWOUTT), 1024, (j / 16) * 64, (j % 16) * 64, fs); }
        else if (it < J5) { int j = it - J4; int m = j >> 2, q = j & 3; transpose_tile(p.w_a + (size_t)m * 16384, 128, (bf16_t*)(p.ws + OFF_WAT) + (size_t)m * 16384, 128, (q >> 1) * 64, (q & 1) * 64, fs); }
        else if (it < J6) { int j = it - J5; int m = j >> 2, q = j & 3; transpose_tile(p.w_x + (size_t)m * 16384, 128, (bf16_t*)(p.ws + OFF_WXT) + (size_t)m * 16384, 128, (q >> 1) * 64, (q & 1) * 64, fs); }
        else { int j = it - J6; bf16_t* d = (bf16_t*)(p.ws + OFF_SGW);
#pragma unroll
            for (int e = 0; e < 8; ++e) { int idx = j * 4096 + e * 512 + tid; d[idx] = f2bf(p.sg_w[idx]); } }
    }
}

__device__ void phase_modulate(const Params& p) {
    const float* mod = (const float*)(p.ws + OFF_MOD);
    bf16_t* h = (bf16_t*)(p.ws + OFF_H);
    const int tid = tid_fresh();
    for (int i = blockIdx.x * 512 + tid; i < TOK * 128; i += gridDim.x * 512) {
        const int row = i >> 7, col = (i & 127) * 8, b = row >> 12;
        const float* xr = p.x + (size_t)row * 1024 + col;
        f32x4 v0 = *(const f32x4*)xr, v1 = *(const f32x4*)(xr + 4);
        const float* sh = mod + b * 3072 + col; const float* scl = sh + 1024;
        f32x4 s0 = *(const f32x4*)sh, s1 = *(const f32x4*)(sh + 4), c0 = *(const f32x4*)scl, c1 = *(const f32x4*)(scl + 4);
#ifdef DBG_NOMOD
        s0 = s1 = c0 = c1 = (f32x4){0.f, 0.f, 0.f, 0.f};
#endif
        u32x4 o;
        o[0] = pack2(v0[0] * (1.f + c0[0]) + s0[0], v0[1] * (1.f + c0[1]) + s0[1]);
        o[1] = pack2(v0[2] * (1.f + c0[2]) + s0[2], v0[3] * (1.f + c0[3]) + s0[3]);
        o[2] = pack2(v1[0] * (1.f + c1[0]) + s1[0], v1[1] * (1.f + c1[1]) + s1[1]);
        o[3] = pack2(v1[2] * (1.f + c1[2]) + s1[2], v1[3] * (1.f + c1[3]) + s1[3]);
        *(u32x4*)(h + (size_t)row * 1024 + col) = o;
    }
}

constexpr int GBM = 256, GBK = 64, GHALF = 128, GHT = GHALF * GBK, GK = 1024;
__device__ __forceinline__ int lds_byte(int r, int c) { int st = (r >> 4) * 2 + (c >> 5), rr = r & 15, cc = c & 31, ob = rr * 64 + cc * 2; return st * 1024 + (ob ^ (((ob >> 9) & 1) << 5)); }
__device__ __forceinline__ void stage_rc(int b, int& R, int& C) { int st = b / 1024, sb = b % 1024, swz = sb ^ (((sb >> 9) & 1) << 5); R = (st >> 1) * 16 + swz / 64; C = (st & 1) * 32 + (swz % 64) / 2; }

template <class Epi>
__device__ __forceinline__ void gemm_tile(const bf16_t* __restrict__ A, const bf16_t* __restrict__ Bt, const int brow, const int bcol, LAS unsigned char* shm, const Epi& epi) {
#define SA(b, h) (shm + ((b) * 2 + (h)) * (GHT * 2))
#define SB(b, h) (shm + (4 + (b) * 2 + (h)) * (GHT * 2))
#define STAGE(P, BASE, br, kt) do { const char* _gb = (const char*)(BASE) + ((long)(br) * GK + (long)(kt) * GBK) * 2; \
    _Pragma("unroll") for (int _i = 0; _i < 2; ++_i) { \
      __builtin_amdgcn_global_load_lds((const unsigned*)(_gb + voff[_i]), (LAS unsigned*)((P) + ldsw + _i * 8192), 16, 0, 0); } } while (0)
#define LDA(dst, b, h) do { _Pragma("unroll") for (int m = 0; m < 4; ++m) _Pragma("unroll") for (int k = 0; k < 2; ++k) \
    dst[m][k] = *(const LAS bf16x8*)(SA(b, h) + aoff + m * 2048 + k * 1024); } while (0)
#define LDB(dst, b, h) do { _Pragma("unroll") for (int n = 0; n < 2; ++n) _Pragma("unroll") for (int k = 0; k < 2; ++k) \
    dst[n][k] = *(const LAS bf16x8*)(SB(b, h) + boff + n * 2048 + k * 1024); } while (0)
#define MMA(ai, bj, At_, Bt_) do { __builtin_amdgcn_s_setprio(1); \
    _Pragma("unroll") for (int m = 0; m < 4; ++m) _Pragma("unroll") for (int n = 0; n < 2; ++n) _Pragma("unroll") for (int k = 0; k < 2; ++k) \
      acc[ai][bj][m][n] = __builtin_amdgcn_mfma_f32_16x16x32_bf16(Bt_[n][k], At_[m][k], acc[ai][bj][m][n], 0, 0, 0); \
    __builtin_amdgcn_s_setprio(0); } while (0)
#define WAIT_V(n) asm volatile("s_waitcnt vmcnt(" #n ")" ::: "memory")
#define WAIT_L(n) asm volatile("s_waitcnt lgkmcnt(" #n ")" ::: "memory")
#define BAR __builtin_amdgcn_s_barrier()
#define SCHED __builtin_amdgcn_sched_barrier(0)
    const int tidx = tid_fresh();
    const int wid = tidx >> 6, lane = tidx & 63, wr = wid >> 2, wc = wid & 3, fr = lane & 15, fq = lane >> 4;
    const int aoff = lds_byte(wr * 64 + fr, fq * 8), boff = lds_byte(wc * 32 + fr, fq * 8), ldsw = tidx * 16;
    int voff[2];
#pragma unroll
    for (int i = 0; i < 2; ++i) { int r_, c_; stage_rc(tidx * 16 + i * 8192, r_, c_); voff[i] = (r_ * GK + c_) * 2; }
    f32x4 acc[2][2][4][2];
#pragma unroll
    for (int a = 0; a < 2; ++a)
#pragma unroll
        for (int b = 0; b < 2; ++b)
#pragma unroll
            for (int m = 0; m < 4; ++m)
#pragma unroll
                for (int n = 0; n < 2; ++n) acc[a][b][m][n] = (f32x4){0.f, 0.f, 0.f, 0.f};
    bf16x8 At[4][2], B0[2][2], B1[2][2];
    constexpr int nt = GK / GBK;
    STAGE(SB(0, 0), Bt, bcol, 0); STAGE(SA(0, 0), A, brow, 0);
    STAGE(SB(0, 1), Bt, bcol + GHALF, 0); STAGE(SA(0, 1), A, brow + GHALF, 0);
    if (wr == 1) BAR;
    WAIT_V(4); BAR;
    STAGE(SB(1, 0), Bt, bcol, 1); STAGE(SA(1, 0), A, brow, 1); STAGE(SB(1, 1), Bt, bcol + GHALF, 1);
    WAIT_V(6); BAR;
    for (int t = 0; t < nt - 2; t += 2) {
        LDB(B0, 0, 0); SCHED; LDA(At, 0, 0); STAGE(SA(1, 1), A, brow + GHALF, t + 1);
        WAIT_L(8); BAR; WAIT_L(0); MMA(0, 0, At, B0); BAR; SCHED;
        LDB(B1, 0, 1); STAGE(SB(0, 0), Bt, bcol, t + 2);
        BAR; WAIT_L(0); MMA(0, 1, At, B1); BAR;
        LDA(At, 0, 1); STAGE(SA(0, 0), A, brow, t + 2);
        BAR; WAIT_L(0); MMA(1, 0, At, B0); BAR; SCHED;
        STAGE(SB(0, 1), Bt, bcol + GHALF, t + 2);
        WAIT_V(6); BAR; MMA(1, 1, At, B1); BAR;
        LDB(B0, 1, 0); SCHED; LDA(At, 1, 0); STAGE(SA(0, 1), A, brow + GHALF, t + 2);
        WAIT_L(8); BAR; WAIT_L(0); MMA(0, 0, At, B0); BAR; SCHED;
        LDB(B1, 1, 1); STAGE(SB(1, 0), Bt, bcol, t + 3);
        BAR; WAIT_L(0); MMA(0, 1, At, B1); BAR;
        LDA(At, 1, 1); STAGE(SA(1, 0), A, brow, t + 3);
        BAR; WAIT_L(0); MMA(1, 0, At, B0); BAR; SCHED;
        STAGE(SB(1, 1), Bt, bcol + GHALF, t + 3);
        WAIT_V(6); BAR; MMA(1, 1, At, B1); BAR;
    }
    { LDB(B0, 0, 0); LDA(At, 0, 0); STAGE(SA(1, 1), A, brow + GHALF, nt - 1);
      BAR; WAIT_L(0); MMA(0, 0, At, B0); BAR;
      LDB(B1, 0, 1); BAR; WAIT_L(0); MMA(0, 1, At, B1); BAR;
      LDA(At, 0, 1); WAIT_V(4); BAR; WAIT_L(0); MMA(1, 0, At, B0); MMA(1, 1, At, B1); BAR; }
    { LDB(B0, 1, 0); LDA(At, 1, 0); WAIT_V(2); BAR; WAIT_L(0); MMA(0, 0, At, B0); BAR;
      LDB(B1, 1, 1); WAIT_V(0); BAR; WAIT_L(0); MMA(0, 1, At, B1); BAR;
      LDA(At, 1, 1); BAR; WAIT_L(0); MMA(1, 0, At, B0); MMA(1, 1, At, B1); BAR; }
    if (wr == 0) BAR;
    epi(acc, brow, bcol, wr, wc, fr, fq);
    __syncthreads();
#undef SA
#undef SB
#undef STAGE
#undef LDA
#undef LDB
#undef MMA
}

template <class Epi>
__device__ __forceinline__ void gemm_phase(const bf16_t* A, const bf16_t* Bt, int N, LAS unsigned char* shm, const Epi& epi) {
    const int nM = TOK / GBM, nN = N / GBM, nwg = nM * nN;
    for (int L = blockIdx.x; L < nwg; L += gridDim.x) {
        int wgid = L; { const int q = nwg / 8, r = nwg % 8, xcd = wgid % 8, off = wgid / 8; wgid = (xcd < r ? xcd * (q + 1) : r * (q + 1) + (xcd - r) * q) + off; }
        const int nig = 8 * nN, gid = wgid / nig, fm = gid * 8, gsz = (nM - fm) < 8 ? (nM - fm) : 8;
        const int pm = fm + ((wgid % nig) % gsz), pn = (wgid % nig) / gsz;
        gemm_tile(A, Bt, pm * GBM, pn * GBM, shm, epi);
    }
}

struct EpiProj0 {
    bf16_t* O; const int* pos;
    __device__ __forceinline__ void operator()(const f32x4 (&acc)[2][2][4][2], int brow, int bcol, int wr, int wc, int fr, int fq) const {
#pragma unroll
        for (int ai = 0; ai < 2; ++ai)
#pragma unroll
            for (int m = 0; m < 4; ++m) {
                const int row = brow + ai * 128 + wr * 64 + m * 16 + fr;
                const float posf = (float)pos[row];
#pragma unroll
                for (int bj = 0; bj < 2; ++bj)
#pragma unroll
                    for (int n = 0; n < 2; ++n) {
                        const int ctile = bcol + bj * 128 + wc * 32 + n * 16;
                        f32x4 v = acc[ai][bj][m][n];
                        if (ctile < 640 && (ctile & 63) == 0) {
#pragma unroll
                            for (int r = 0; r < 4; ++r) {
                                const float partner = __shfl_xor(v[r], 32);
                                const int i = (fq & 1) * 4 + r;
                                const float invf = exp2f(-(float)i * 2.3664460711655218f);
                                const float ang = posf * invf;
                                const float kf = rintf(ang * 0.15915494309189535f);
                                float red = fmaf(-kf, 6.28318548202514648f, ang);
                                red = fmaf(kf, 1.7484556e-7f, red);
                                const float sn = __sinf(red), cs = __cosf(red);
                                v[r] = (fq < 2) ? (v[r] * cs - partner * sn) : (v[r] * cs + partner * sn);
                            }
                        }
                        if (ctile < 512) { v[0] *= 0.125f; v[1] *= 0.125f; v[2] *= 0.125f; v[3] *= 0.125f; }
                        u32x2 o; o[0] = pack2(v[0], v[1]); o[1] = pack2(v[2], v[3]);
                        *(u32x2*)(O + (size_t)row * EW + ctile + fq * 4) = o;
                    }
            }
    }
};
struct EpiBf16 {
    bf16_t* O; int ld;
    __device__ __forceinline__ void operator()(const f32x4 (&acc)[2][2][4][2], int brow, int bcol, int wr, int wc, int fr, int fq) const {
#pragma unroll
        for (int ai = 0; ai < 2; ++ai)
#pragma unroll
            for (int m = 0; m < 4; ++m) {
                const int row = brow + ai * 128 + wr * 64 + m * 16 + fr;
#pragma unroll
                for (int bj = 0; bj < 2; ++bj)
#pragma unroll
                    for (int n = 0; n < 2; ++n) {
                        const int col = bcol + bj * 128 + wc * 32 + n * 16 + fq * 4;
                        f32x4 v = acc[ai][bj][m][n];
                        u32x2 o; o[0] = pack2(v[0], v[1]); o[1] = pack2(v[2], v[3]);
                        *(u32x2*)(O + (size_t)row * ld + col) = o;
                    }
            }
    }
};
struct EpiRes {
    float* Z; const float* X; const float* gate;
    __device__ __forceinline__ void operator()(const f32x4 (&acc)[2][2][4][2], int brow, int bcol, int wr, int wc, int fr, int fq) const {
#pragma unroll
        for (int ai = 0; ai < 2; ++ai)
#pragma unroll
            for (int m = 0; m < 4; ++m) {
                const int row = brow + ai * 128 + wr * 64 + m * 16 + fr;
                const int b = row >> 12;
#pragma unroll
                for (int bj = 0; bj < 2; ++bj)
#pragma unroll
                    for (int n = 0; n < 2; ++n) {
                        const int col = bcol + bj * 128 + wc * 32 + n * 16 + fq * 4;
                        const f32x4 xv = *(const f32x4*)(X + (size_t)row * 1024 + col);
                        const f32x4 gv = *(const f32x4*)(gate + b * 3072 + col);
                        *(f32x4*)(Z + (size_t)row * 1024 + col) = ALPHA * xv + gv * acc[ai][bj][m][n];
                    }
            }
    }
};

constexpr int KS_LD = 72, VT_LD = 392;
__device__ void attn_item(const Params& p, int item, unsigned char* smem) {
    const bf16_t* proj = (const bf16_t*)(p.ws + OFF_PROJ);
    bf16_t* y = (bf16_t*)(p.ws + OFF_Y);
    const int b = item >> 6, n = (item >> 1) & 31, h = item & 1;
    const int tid = tid_fresh(), w = tid >> 6, lane = tid & 63, fr = lane & 15, fq = lane >> 4;
    bf16_t* Ks = (bf16_t*)smem;
    bf16_t* Vt = Ks + 384 * KS_LD;
    for (int e = tid; e < 384 * 8; e += 512) {
        const int kj = e >> 3, ch = e & 7;
        const int s = n * 128 - 128 + kj;
        u32x4 kv = {0u, 0u, 0u, 0u}, vv = {0u, 0u, 0u, 0u};
        if (s >= 0 && s < SEQ) {
            const bf16_t* row = proj + (size_t)(b * SEQ + s) * EW;
            kv = *(const u32x4*)(row + 512 + h * 64 + ch * 8);
            vv = *(const u32x4*)(row + 640 + h * 64 + ch * 8);
        }
        *(u32x4*)(Ks + kj * KS_LD + ch * 8) = kv;
#pragma unroll
        for (int j = 0; j < 8; ++j) Vt[(ch * 8 + j) * VT_LD + kj] = (bf16_t)(vv[j >> 1] >> ((j & 1) * 16));
    }
    __syncthreads();
    const int tok = b * SEQ + n * 128 + w * 16 + fr;
    for (int g = 0; g < 4; ++g) {
        const int qh = h * 4 + g;
        const bf16_t* qrow = proj + (size_t)tok * EW + qh * 64;
        const bf16x8 q0 = *(const bf16x8*)(qrow + fq * 8), q1 = *(const bf16x8*)(qrow + 32 + fq * 8);
        f32x4 S[17];
#pragma unroll
        for (int tt = 0; tt < 17; ++tt) {
            const bf16_t* kp = Ks + ((w + tt) * 16 + fr) * KS_LD + fq * 8;
            const bf16x8 k0 = *(const bf16x8*)kp, k1 = *(const bf16x8*)(kp + 32);
            f32x4 a = {0.f, 0.f, 0.f, 0.f};
            a = __builtin_amdgcn_mfma_f32_16x16x32_bf16(k0, q0, a, 0, 0, 0);
            a = __builtin_amdgcn_mfma_f32_16x16x32_bf16(k1, q1, a, 0, 0, 0);
            S[tt] = a;
            asm volatile("" ::: "memory");
        }
        const float sink = p.ev_sink[qh];
        float mx = sink;
#pragma unroll
        for (int tt = 0; tt < 17; ++tt)
#pragma unroll
            for (int r = 0; r < 4; ++r) {
                const int b16 = n * 8 - 8 + w + tt;
                float v = (b16 >= 0 && b16 < SEQ / 16) ? S[tt][r] : -1e30f;
                if (tt == 0) v = (fq * 4 + r >= fr) ? v : -1e30f;
                if (tt == 16) v = (fq * 4 + r <= fr) ? v : -1e30f;
                S[tt][r] = v; mx = fmaxf(mx, v);
            }
        mx = fmaxf(mx, __shfl_xor(mx, 16)); mx = fmaxf(mx, __shfl_xor(mx, 32));
        float sum = 0.f;
#pragma unroll
        for (int tt = 0; tt < 17; ++tt)
#pragma unroll
            for (int r = 0; r < 4; ++r) { const float e = __expf(S[tt][r] - mx); S[tt][r] = e; sum += e; }
        sum += __shfl_xor(sum, 16); sum += __shfl_xor(sum, 32);
        const float inv = 1.f / (sum + __expf(sink - mx));
        f32x4 O[4];
#pragma unroll
        for (int dt = 0; dt < 4; ++dt) O[dt] = (f32x4){0.f, 0.f, 0.f, 0.f};
#pragma unroll
        for (int pp = 0; pp < 8; ++pp) {
            const int t0 = 2 * pp, t1 = 2 * pp + 1;
            u32x4 pu; pu[0] = pack2(S[t0][0], S[t0][1]); pu[1] = pack2(S[t0][2], S[t0][3]); pu[2] = pack2(S[t1][0], S[t1][1]); pu[3] = pack2(S[t1][2], S[t1][3]);
            const bf16x8 pf = __builtin_bit_cast(bf16x8, pu);
#pragma unroll
            for (int dt = 0; dt < 4; ++dt) {
                const bf16_t* vp = Vt + (dt * 16 + fr) * VT_LD + (w + t0) * 16 + fq * 4;
                u32x4 vu; const u32x2 va = *(const u32x2*)vp, vb = *(const u32x2*)(vp + 16);
                vu[0] = va[0]; vu[1] = va[1]; vu[2] = vb[0]; vu[3] = vb[1];
                O[dt] = __builtin_amdgcn_mfma_f32_16x16x32_bf16(__builtin_bit_cast(bf16x8, vu), pf, O[dt], 0, 0, 0);
            }
            asm volatile("" ::: "memory");
        }
        {
            u32x2 pu; pu[0] = pack2(S[16][0], S[16][1]); pu[1] = pack2(S[16][2], S[16][3]);
            const bf16x4 pf = __builtin_bit_cast(bf16x4, pu);
#pragma unroll
            for (int dt = 0; dt < 4; ++dt) {
                const bf16x4 vf = *(const bf16x4*)(Vt + (dt * 16 + fr) * VT_LD + (w + 16) * 16 + fq * 4);
                O[dt] = __builtin_amdgcn_mfma_f32_16x16x16bf16_1k(vf, pf, O[dt], 0, 0, 0);
            }
        }
#pragma unroll
        for (int dt = 0; dt < 4; ++dt) {
            const int col = qh * 64 + dt * 16 + fq * 4;
            const u32x2 gu = *(const u32x2*)(proj + (size_t)tok * EW + 1792 + col);
            u32x2 o;
            o[0] = pack2(O[dt][0] * inv * silu_f(lo2f(gu[0])), O[dt][1] * inv * silu_f(hi2f(gu[0])));
            o[1] = pack2(O[dt][2] * inv * silu_f(lo2f(gu[1])), O[dt][3] * inv * silu_f(hi2f(gu[1])));
            *(u32x2*)(y + (size_t)tok * 1024 + col) = o;
        }
    }
    __syncthreads();
}

constexpr int VN_LD = 136;
__device__ void sg_item(const Params& p, int item, unsigned char* smem) {
    const bf16_t* proj = (const bf16_t*)(p.ws + OFF_PROJ);
    const bf16_t* sgw = (const bf16_t*)(p.ws + OFF_SGW);
    bf16_t* y = (bf16_t*)(p.ws + OFF_Y);
    const int b = item >> 8, c = (item >> 3) & 31, gi = item & 7;
    const int tid = tid_fresh(), w = tid >> 6, lane = tid & 63, fr = lane & 15, fq = lane >> 4;
    bf16_t* vnT = (bf16_t*)smem;
    const int tok0 = b * SEQ + c * 128;
    {
        const int q = tid >> 2, part = tid & 3;
        const bf16_t* src = proj + (size_t)(tok0 + q) * EW + 1280 + gi * 64 + part * 16;
        const u32x4 r0 = *(const u32x4*)src, r1 = *(const u32x4*)(src + 8);
        float v[16];
#pragma unroll
        for (int j = 0; j < 4; ++j) { v[2 * j] = lo2f(r0[j]); v[2 * j + 1] = hi2f(r0[j]); v[8 + 2 * j] = lo2f(r1[j]); v[8 + 2 * j + 1] = hi2f(r1[j]); }
        float s = 0.f;
#pragma unroll
        for (int j = 0; j < 16; ++j) s += v[j];
        s += __shfl_xor(s, 1); s += __shfl_xor(s, 2);
        const float mu = s * (1.f / 64.f);
        float ss = 0.f;
#pragma unroll
        for (int j = 0; j < 16; ++j) { const float d = v[j] - mu; ss += d * d; }
        ss += __shfl_xor(ss, 1); ss += __shfl_xor(ss, 2);
        const float rs = rsqrtf(ss * (1.f / 64.f) + 1e-5f);
#pragma unroll
        for (int j = 0; j < 16; ++j) {
            const int d = part * 16 + j;
            const float vn = (v[j] - mu) * rs * p.sg_ln_g[gi * 64 + d] + p.sg_ln_b[gi * 64 + d];
            vnT[d * VN_LD + q] = f2bf(vn);
        }
    }
    __syncthreads();
    const bf16_t* wrow = sgw + (size_t)(gi * 128 + w * 16 + fr) * 128 + fq * 8;
    bf16x8 wf[4];
#pragma unroll
    for (int kk = 0; kk < 4; ++kk) wf[kk] = *(const bf16x8*)(wrow + kk * 32);
    f32x4 acc[4];
#pragma unroll
    for (int dt = 0; dt < 4; ++dt) {
        acc[dt] = (f32x4){0.f, 0.f, 0.f, 0.f};
#pragma unroll
        for (int kk = 0; kk < 4; ++kk) {
            const bf16x8 vf = *(const bf16x8*)(vnT + (dt * 16 + fr) * VN_LD + kk * 32 + fq * 8);
            acc[dt] = __builtin_amdgcn_mfma_f32_16x16x32_bf16(vf, wf[kk], acc[dt], 0, 0, 0);
        }
    }
    const int prow = w * 16 + fr, tok = tok0 + prow;
    const float bs = p.sg_b[gi * 128 + prow];
#pragma unroll
    for (int dt = 0; dt < 4; ++dt) {
        const int col = gi * 64 + dt * 16 + fq * 4;
        const u32x2 su = *(const u32x2*)(proj + (size_t)tok * EW + 768 + col);
        const u32x2 gu = *(const u32x2*)(proj + (size_t)tok * EW + 1792 + 512 + col);
        u32x2 o;
        o[0] = pack2((acc[dt][0] + bs) * lo2f(su[0]) * silu_f(lo2f(gu[0])), (acc[dt][1] + bs) * hi2f(su[0]) * silu_f(hi2f(gu[0])));
        o[1] = pack2((acc[dt][2] + bs) * lo2f(su[1]) * silu_f(lo2f(gu[1])), (acc[dt][3] + bs) * hi2f(su[1]) * silu_f(hi2f(gu[1])));
        *(u32x2*)(y + (size_t)tok * 1024 + 512 + col) = o;
    }
    __syncthreads();
}

__device__ void ln_phase(const Params& p, const float* __restrict__ z, float* __restrict__ xo, bf16_t* __restrict__ ho, const float* g, const float* bb, const float* modn) {
    const int tid = tid_fresh();
    const int w = tid >> 6, lane = tid & 63;
    for (int row = blockIdx.x * 8 + w; row < TOK; row += gridDim.x * 8) {
        const float* zr = z + (size_t)row * 1024;
        f32x4 v[4];
#pragma unroll
        for (int i = 0; i < 4; ++i) v[i] = *(const f32x4*)(zr + i * 256 + lane * 4);
        float s = 0.f;
#pragma unroll
        for (int i = 0; i < 4; ++i) s += v[i][0] + v[i][1] + v[i][2] + v[i][3];
#pragma unroll
        for (int o = 32; o >= 1; o >>= 1) s += __shfl_xor(s, o);
        const float mu = s * (1.f / 1024.f);
        float ss = 0.f;
#pragma unroll
        for (int i = 0; i < 4; ++i)
#pragma unroll
            for (int j = 0; j < 4; ++j) { const float d = v[i][j] - mu; ss += d * d; }
#pragma unroll
        for (int o = 32; o >= 1; o >>= 1) ss += __shfl_xor(ss, o);
        const float rs = rsqrtf(ss * (1.f / 1024.f) + 1e-5f);
        const int b = row >> 12;
#pragma unroll
        for (int i = 0; i < 4; ++i) {
            const int col = i * 256 + lane * 4;
            const f32x4 gv = *(const f32x4*)(g + col), bv = *(const f32x4*)(bb + col);
            f32x4 o;
#pragma unroll
            for (int j = 0; j < 4; ++j) o[j] = (v[i][j] - mu) * rs * gv[j] + bv[j];
            *(f32x4*)(xo + (size_t)row * 1024 + col) = o;
            if (ho) {
                const f32x4 sh = *(const f32x4*)(modn + b * 3072 + col), sc = *(const f32x4*)(modn + b * 3072 + 1024 + col);
                u32x2 hu; hu[0] = pack2(o[0] * (1.f + sc[0]) + sh[0], o[1] * (1.f + sc[1]) + sh[1]); hu[1] = pack2(o[2] * (1.f + sc[2]) + sh[2], o[3] * (1.f + sc[3]) + sh[3]);
                *(u32x2*)(ho + (size_t)row * 1024 + col) = hu;
            }
        }
    }
}

constexpr int XC_LD = 136;
__device__ void lru_item(const Params& p, int item, unsigned char* smem) {
    const bf16_t* proj = (const bf16_t*)(p.ws + OFF_PROJ);
    bf16_t* Sarr = (bf16_t*)(p.ws + OFF_Z);
    bf16_t* Pfarr = Sarr + (size_t)TOK * 1024;
    bf16_t* Pbarr = (bf16_t*)(p.ws + OFF_H);
    float* sums = (float*)(p.ws + OFF_SUM);
    const int hd = item & 7, c = (item >> 3) & 31, b = item >> 8;
    const int tid = tid_fresh(), w = tid >> 6, lane = tid & 63, fr = lane & 15, fq = lane >> 4;
    bf16_t* Xc = (bf16_t*)smem;
    const int tok0 = b * SEQ + c * 128;
    {
        const int cg8 = tid & 15, tg = tid >> 4;
        const int ch0 = hd * 128 + cg8 * 8;
        float cw[4][8], cbv[8];
#pragma unroll
        for (int k = 0; k < 4; ++k) { const f32x4 a = *(const f32x4*)(p.conv_w + k * 1024 + ch0), bq = *(const f32x4*)(p.conv_w + k * 1024 + ch0 + 4);
#pragma unroll
            for (int j = 0; j < 4; ++j) { cw[k][j] = a[j]; cw[k][4 + j] = bq[j]; } }
        { const f32x4 a = *(const f32x4*)(p.conv_b + ch0), bq = *(const f32x4*)(p.conv_b + ch0 + 4);
#pragma unroll
            for (int j = 0; j < 4; ++j) { cbv[j] = a[j]; cbv[4 + j] = bq[j]; } }
        float xin[7][8];
#pragma unroll
        for (int i = 0; i < 7; ++i) {
            const int s = c * 128 + tg * 4 - 2 + i;
            u32x4 u = {0u, 0u, 0u, 0u};
            if (s >= 0 && s < SEQ) u = *(const u32x4*)(proj + (size_t)(b * SEQ + s) * OW + ch0);
#pragma unroll
            for (int j = 0; j < 4; ++j) { xin[i][2 * j] = lo2f(u[j]); xin[i][2 * j + 1] = hi2f(u[j]); }
        }
#pragma unroll
        for (int rr = 0; rr < 4; ++rr) {
            float o[8];
#pragma unroll
            for (int j = 0; j < 8; ++j) o[j] = cbv[j] + cw[0][j] * xin[rr][j] + cw[1][j] * xin[rr + 1][j] + cw[2][j] * xin[rr + 2][j] + cw[3][j] * xin[rr + 3][j];
            u32x4 ou; ou[0] = pack2(o[0], o[1]); ou[1] = pack2(o[2], o[3]); ou[2] = pack2(o[4], o[5]); ou[3] = pack2(o[6], o[7]);
            *(u32x4*)(Xc + (tg * 4 + rr) * XC_LD + cg8 * 8) = ou;
        }
    }
    __syncthreads();
    const int ch = hd * 128 + w * 16 + fr;
    float hf[8][4];
#pragma unroll
    for (int dir = 0; dir < 2; ++dir) {
        const bf16_t* wa_row = (const bf16_t*)(p.ws + OFF_WAT) + (size_t)((dir * 8 + hd) * 128 + w * 16 + fr) * 128 + fq * 8;
        const bf16_t* wx_row = (const bf16_t*)(p.ws + OFF_WXT) + (size_t)((dir * 8 + hd) * 128 + w * 16 + fr) * 128 + fq * 8;
        bf16x8 wa[4], wx[4];
#pragma unroll
        for (int kk = 0; kk < 4; ++kk) { wa[kk] = *(const bf16x8*)(wa_row + kk * 32); wx[kk] = *(const bf16x8*)(wx_row + kk * 32); }
        const float ba = p.b_a[dir * 1024 + ch], bx = p.b_x[dir * 1024 + ch];
        const float c8 = 8.f * log1pf(__expf(-p.lam[dir * 1024 + ch]));
        const int fqt = dir ? 3 - fq : fq;
        const int src1 = (dir ? lane + 16 : lane - 16) & 63, src2 = (dir ? lane + 32 : lane - 32) & 63, lastl = dir ? fr : fr + 48;
        float hc = 0.f, Pc = 1.f;
#pragma unroll
        for (int mi = 0; mi < 8; ++mi) {
            const int mt = dir ? 7 - mi : mi;
            f32x4 pr = {0.f, 0.f, 0.f, 0.f}, pi = {0.f, 0.f, 0.f, 0.f};
#pragma unroll
            for (int kk = 0; kk < 4; ++kk) {
                const bf16x8 xa = *(const bf16x8*)(Xc + (mt * 16 + fr) * XC_LD + kk * 32 + fq * 8);
                pr = __builtin_amdgcn_mfma_f32_16x16x32_bf16(xa, wa[kk], pr, 0, 0, 0);
                pi = __builtin_amdgcn_mfma_f32_16x16x32_bf16(xa, wx[kk], pi, 0, 0, 0);
            }
            float av[4], bv[4];
#pragma unroll
            for (int u = 0; u < 4; ++u) {
                const int r = dir ? 3 - u : u;
                const int t = mt * 16 + fq * 4 + r;
                const float xv = bf2f(Xc[t * XC_LD + w * 16 + fr]);
                const float rg = sigmoid_f(pr[r] + ba), ig = sigmoid_f(pi[r] + bx);
                const float la = -c8 * rg;
                av[u] = __expf(la);
                bv[u] = sqrtf(-expm1f(2.f * la)) * ig * xv;
            }
            float Ap[4], Bp[4];
            Ap[0] = av[0]; Bp[0] = bv[0];
#pragma unroll
            for (int u = 1; u < 4; ++u) { Ap[u] = av[u] * Ap[u - 1]; Bp[u] = av[u] * Bp[u - 1] + bv[u]; }
            float IA = Ap[3], IB = Bp[3];
            { const float pa = __shfl(IA, src1), pb = __shfl(IB, src1); if (fqt >= 1) { IB = IA * pb + IB; IA = IA * pa; } }
            { const float pa = __shfl(IA, src2), pb = __shfl(IB, src2); if (fqt >= 2) { IB = IA * pb + IB; IA = IA * pa; } }
            float EA = __shfl(IA, src1), EB = __shfl(IB, src1);
            if (fqt == 0) { EA = 1.f; EB = 0.f; }
            const float hin = EA * hc + EB, Pin = EA * Pc;
            const float TA = __shfl(IA, lastl), TB = __shfl(IB, lastl);
#pragma unroll
            for (int u = 0; u < 4; ++u) {
                const int r = dir ? 3 - u : u;
                const int t = mt * 16 + fq * 4 + r;
                const float hv = Ap[u] * hin + Bp[u], Pv = Ap[u] * Pin;
                const size_t o = (size_t)(tok0 + t) * 1024 + ch;
                if (dir == 0) { hf[mt][r] = hv; Pfarr[o] = f2bf(Pv); }
                else { Sarr[o] = f2bf(hf[mt][r] + hv); Pbarr[o] = f2bf(Pv); }
            }
            hc = TA * hc + TB; Pc = TA * Pc;
            asm volatile("" ::: "memory");
        }
        if (fq == 0) { sums[(size_t)(dir * 2 + 0) * (SUM_SZ / 4) + (size_t)(b * 32 + c) * 1024 + ch] = Pc; sums[(size_t)(dir * 2 + 1) * (SUM_SZ / 4) + (size_t)(b * 32 + c) * 1024 + ch] = hc; }
    }
    __syncthreads();
}

__device__ void combine_item(const Params& p, int item) {
    const bf16_t* proj = (const bf16_t*)(p.ws + OFF_PROJ);
    const bf16_t* Sarr = (const bf16_t*)(p.ws + OFF_Z);
    const bf16_t* Pfarr = Sarr + (size_t)TOK * 1024;
    const bf16_t* Pbarr = (const bf16_t*)(p.ws + OFF_H);
    const float* sums = (const float*)(p.ws + OFF_SUM);
    bf16_t* y = (bf16_t*)(p.ws + OFF_Y);
    const int q = item & 3, c = (item >> 2) & 31, b = item >> 7;
    const int tid = tid_fresh();
    const int cg8 = tid & 127, rg = tid >> 7;
    const float* Af = sums, * Hf = sums + SUM_SZ / 4, * Ab = sums + 2 * (SUM_SZ / 4), * Hb = sums + 3 * (SUM_SZ / 4);
    float cf[8], cb[8];
#pragma unroll
    for (int j = 0; j < 8; ++j) { cf[j] = 0.f; cb[j] = 0.f; }
    for (int c2 = 0; c2 < c; ++c2) {
        const size_t o = (size_t)(b * 32 + c2) * 1024 + cg8 * 8;
        const f32x4 a0 = *(const f32x4*)(Af + o), a1 = *(const f32x4*)(Af + o + 4), h0 = *(const f32x4*)(Hf + o), h1 = *(const f32x4*)(Hf + o + 4);
#pragma unroll
        for (int j = 0; j < 4; ++j) { cf[j] = a0[j] * cf[j] + h0[j]; cf[4 + j] = a1[j] * cf[4 + j] + h1[j]; }
    }
    for (int c2 = 31; c2 > c; --c2) {
        const size_t o = (size_t)(b * 32 + c2) * 1024 + cg8 * 8;
        const f32x4 a0 = *(const f32x4*)(Ab + o), a1 = *(const f32x4*)(Ab + o + 4), h0 = *(const f32x4*)(Hb + o), h1 = *(const f32x4*)(Hb + o + 4);
#pragma unroll
        for (int j = 0; j < 4; ++j) { cb[j] = a0[j] * cb[j] + h0[j]; cb[4 + j] = a1[j] * cb[4 + j] + h1[j]; }
    }
    for (int i = 0; i < 8; ++i) {
        const int tok = b * SEQ + c * 128 + q * 32 + rg * 8 + i;
        const size_t o = (size_t)tok * 1024 + cg8 * 8;
        const u32x4 su = *(const u32x4*)(Sarr + o), fu = *(const u32x4*)(Pfarr + o), bu = *(const u32x4*)(Pbarr + o);
        const u32x4 gu = *(const u32x4*)(proj + (size_t)tok * OW + 1024 + cg8 * 8);
        u32x4 ou;
#pragma unroll
        for (int j = 0; j < 4; ++j) {
            const float v0 = (lo2f(su[j]) + lo2f(fu[j]) * cf[2 * j] + lo2f(bu[j]) * cb[2 * j]) * silu_f(lo2f(gu[j]));
            const float v1 = (hi2f(su[j]) + hi2f(fu[j]) * cf[2 * j + 1] + hi2f(bu[j]) * cb[2 * j + 1]) * silu_f(hi2f(gu[j]));
            ou[j] = pack2(v0, v1);
        }
        *(u32x4*)(y + o) = ou;
    }
}


#ifdef DBG_STOP
#ifndef DBG_COL
#define DBG_COL 0
#endif
__device__ void dbg_copy_f32(const Params& p, const float* src) {
    for (int i = blockIdx.x * 512 + threadIdx.x; i < TOK * 256; i += gridDim.x * 512) ((f32x4*)p.out)[i] = ((const f32x4*)src)[i];
}
__device__ void dbg_copy_bf16(const Params& p, const bf16_t* src, int ld, int coloff) {
    for (int i = blockIdx.x * 512 + threadIdx.x; i < TOK * 1024; i += gridDim.x * 512) { int row = i >> 10, col = i & 1023; p.out[i] = bf2f(src[(size_t)row * ld + coloff + col]); }
}
#define DBG_AT(k, stmt) if (DBG_STOP == k) { stmt; return; }
#else
#define DBG_AT(k, stmt)
#endif
__device__ unsigned g_bar = 0;
__device__ __forceinline__ void gsync(cg::grid_group& g, unsigned* bar, unsigned& epoch) {
    (void)g; (void)bar; (void)epoch;
    __builtin_amdgcn_fence(__ATOMIC_RELEASE, "agent");
    asm volatile("s_waitcnt vmcnt(0) lgkmcnt(0)" ::: "memory");
    __syncthreads();
    if (threadIdx.x == 0) {
        const unsigned nb = gridDim.x;
        const unsigned old = __hip_atomic_fetch_add(&g_bar, 1u, __ATOMIC_ACQ_REL, __HIP_MEMORY_SCOPE_AGENT);
        const unsigned gen = old & 0xffff0000u;
        if ((old & 0xffffu) == nb - 1u) __hip_atomic_fetch_add(&g_bar, 0x10000u - nb, __ATOMIC_ACQ_REL, __HIP_MEMORY_SCOPE_AGENT);
        else while ((__hip_atomic_load(&g_bar, __ATOMIC_RELAXED, __HIP_MEMORY_SCOPE_AGENT) & 0xffff0000u) == gen) __builtin_amdgcn_s_sleep(2);
    }
    __syncthreads();
    __builtin_amdgcn_fence(__ATOMIC_ACQUIRE, "agent");
    asm volatile("s_waitcnt vmcnt(0)" ::: "memory");
}

__global__ void __launch_bounds__(512) fwd_megakernel(Params p) {
    extern __shared__ __attribute__((aligned(16))) unsigned char shm[];
    cg::grid_group grid = cg::this_grid();
    LAS unsigned char* lshm = (LAS unsigned char*)shm;
    const float* mod = (const float*)(p.ws + OFF_MOD);
    unsigned* bar = (unsigned*)(p.ws + OFF_BAR);
    unsigned epoch = 0;
    DBG_AT(-1, dbg_copy_f32(p, p.x))
    grid.sync();

    phase0(p, shm);
    gsync(grid, bar, epoch);
    DBG_AT(0, dbg_copy_f32(p, (const float*)(p.ws + OFF_MOD - (size_t)0)))
    phase_modulate(p);
    gsync(grid, bar, epoch);
    DBG_AT(1, dbg_copy_bf16(p, (const bf16_t*)(p.ws + OFF_H), 1024, 0))
    { EpiProj0 e{(bf16_t*)(p.ws + OFF_PROJ), p.pos}; gemm_phase((const bf16_t*)(p.ws + OFF_H), (const bf16_t*)(p.ws + OFF_WINT), EW, lshm, e); }
    gsync(grid, bar, epoch);
    DBG_AT(2, dbg_copy_bf16(p, (const bf16_t*)(p.ws + OFF_PROJ), EW, DBG_COL))
    for (int it = blockIdx.x; it < 256; it += gridDim.x) attn_item(p, it, shm);
    for (int it = blockIdx.x; it < 1024; it += gridDim.x) sg_item(p, it, shm);
    gsync(grid, bar, epoch);
    DBG_AT(3, dbg_copy_bf16(p, (const bf16_t*)(p.ws + OFF_Y), 1024, 0))
    { EpiRes e{(float*)(p.ws + OFF_Z), p.x, mod + 2048}; gemm_phase((const bf16_t*)(p.ws + OFF_Y), (const bf16_t*)(p.ws + OFF_WOUTT), 1024, lshm, e); }
    gsync(grid, bar, epoch);
    DBG_AT(4, dbg_copy_f32(p, (const float*)(p.ws + OFF_Z)))
    ln_phase(p, (const float*)(p.ws + OFF_Z), p.out, (bf16_t*)(p.ws + OFF_H), p.ln_g, p.ln_b, mod + 4 * 3072);
    gsync(grid, bar, epoch);
    DBG_AT(5, )
    { EpiBf16 e{(bf16_t*)(p.ws + OFF_PROJ), OW}; gemm_phase((const bf16_t*)(p.ws + OFF_H), (const bf16_t*)(p.ws + OFF_OWINT), OW, lshm, e); }
    gsync(grid, bar, epoch);
    DBG_AT(6, dbg_copy_bf16(p, (const bf16_t*)(p.ws + OFF_PROJ), OW, DBG_COL))
    for (int it = blockIdx.x; it < 1024; it += gridDim.x) lru_item(p, it, shm);
    gsync(grid, bar, epoch);
    DBG_AT(7, dbg_copy_bf16(p, (const bf16_t*)(p.ws + OFF_Z), 1024, 0))
    for (int it = blockIdx.x; it < 512; it += gridDim.x) combine_item(p, it);
    gsync(grid, bar, epoch);
    DBG_AT(8, dbg_copy_bf16(p, (const bf16_t*)(p.ws + OFF_Y), 1024, 0))
    { EpiRes e{(float*)(p.ws + OFF_Z), p.out, mod + 4 * 3072 + 2048}; gemm_phase((const bf16_t*)(p.ws + OFF_Y), (const bf16_t*)(p.ws + OFF_OWOUTT), 1024, lshm, e); }
    gsync(grid, bar, epoch);
    DBG_AT(9, dbg_copy_f32(p, (const float*)(p.ws + OFF_Z)))
    ln_phase(p, (const float*)(p.ws + OFF_Z), p.out, nullptr, p.ln_g + 1024, p.ln_b + 1024, nullptr);
}

extern "C" void kernel_launch(void* const* d_in, const int* in_sizes, int n_in, void* d_out, int out_size, void* d_ws, size_t ws_size, hipStream_t stream) {
    static int grid_blocks = 0;
    if (grid_blocks == 0) {
        if (ws_size < WS_END) { fprintf(stderr, "kernel_launch: workspace too small (%zu < %zu)\n", ws_size, (size_t)WS_END); grid_blocks = -1; return; }
        int dev = 0, cus = 0, per_cu = 0;
        hipGetDevice(&dev);
        hipDeviceGetAttribute(&cus, hipDeviceAttributeMultiprocessorCount, dev);
        if (hipFuncSetAttribute((const void*)fwd_megakernel, hipFuncAttributeMaxDynamicSharedMemorySize, LDS_BYTES) != hipSuccess) { fprintf(stderr, "kernel_launch: hipFuncSetAttribute failed\n"); grid_blocks = -1; return; }
        if (hipOccupancyMaxActiveBlocksPerMultiprocessor(&per_cu, (const void*)fwd_megakernel, 512, LDS_BYTES) != hipSuccess || per_cu < 1) { fprintf(stderr, "kernel_launch: occupancy query failed (%d)\n", per_cu); per_cu = 1; (void)hipGetLastError(); }
        if (per_cu > 1) per_cu = 1;
        grid_blocks = cus * per_cu;
    }
    if (grid_blocks < 0) return;
    Params p{};
    p.x = (const float*)d_in[0]; p.c = (const float*)d_in[1]; p.pos = (const int*)d_in[2]; p.ada_w = (const float*)d_in[3]; p.ada_b = (const float*)d_in[4];
    p.ln_g = (const float*)d_in[5]; p.ln_b = (const float*)d_in[6]; p.ev_w_in = (const float*)d_in[7]; p.ev_w_out = (const float*)d_in[8]; p.ev_sink = (const float*)d_in[9];
    p.sg_ln_g = (const float*)d_in[10]; p.sg_ln_b = (const float*)d_in[11]; p.sg_w = (const float*)d_in[12]; p.sg_b = (const float*)d_in[13];
    p.od_w_in = (const float*)d_in[14]; p.conv_w = (const float*)d_in[15]; p.conv_b = (const float*)d_in[16]; p.w_a = (const float*)d_in[17]; p.b_a = (const float*)d_in[18];
    p.w_x = (const float*)d_in[19]; p.b_x = (const float*)d_in[20]; p.lam = (const float*)d_in[21]; p.od_w_out = (const float*)d_in[22];
    p.out = (float*)d_out; p.ws = (unsigned char*)d_ws;
    if (hipMemsetAsync((char*)d_ws + OFF_BAR, 0, 256, stream) != hipSuccess) { fprintf(stderr, "kernel_launch: memset failed\n"); return; }
    void* args[] = {&p};
    hipError_t e = hipLaunchCooperativeKernel((const void*)fwd_megakernel, dim3(grid_blocks), dim3(512), args, LDS_BYTES, stream);
    if (e != hipSuccess) fprintf(stderr, "cooperative launch failed: %s (grid %d)\n", hipGetErrorString(e), grid_blocks);
}
```

```cpp
#ifndef REP_MASK
#define REP_MASK 0
#endif
#include <hip/hip_runtime.h>
#include <hip/hip_cooperative_groups.h>
#include <cstdio>
namespace cg = cooperative_groups;

#define LAS __attribute__((address_space(3)))
typedef unsigned short bf16_t;
typedef short bf16x8 __attribute__((ext_vector_type(8)));
typedef short bf16x4 __attribute__((ext_vector_type(4)));
typedef float f32x4 __attribute__((ext_vector_type(4)));
typedef unsigned u32x4 __attribute__((ext_vector_type(4)));
typedef unsigned u32x2 __attribute__((ext_vector_type(2)));

constexpr int TOK = 16384, DM = 1024, SEQ = 4096;
constexpr int EW = 2816;
constexpr int OW = 2048;
constexpr float ALPHA = 1.41421356237f;

constexpr size_t OFF_WINT = 0;
constexpr size_t OFF_WOUTT = OFF_WINT + (size_t)2816 * 1024 * 2;
constexpr size_t OFF_OWINT = OFF_WOUTT + (size_t)1024 * 1024 * 2;
constexpr size_t OFF_OWOUTT = OFF_OWINT + (size_t)2048 * 1024 * 2;
constexpr size_t OFF_WAT = OFF_OWOUTT + (size_t)1024 * 1024 * 2;
constexpr size_t OFF_WXT = OFF_WAT + (size_t)16 * 128 * 128 * 2;
constexpr size_t OFF_SGW = OFF_WXT + (size_t)16 * 128 * 128 * 2;
constexpr size_t OFF_MOD = OFF_SGW + (size_t)8 * 128 * 128 * 2;
constexpr size_t OFF_SUM = OFF_MOD + (size_t)2 * 4 * 3072 * 4;
constexpr size_t SUM_SZ = (size_t)4 * 32 * 1024 * 4;
constexpr size_t OFF_H = OFF_SUM + 4 * SUM_SZ;
constexpr size_t OFF_PROJ = OFF_H + (size_t)TOK * 1024 * 2;
constexpr size_t OFF_Y = OFF_PROJ + (size_t)TOK * 2816 * 2;
constexpr size_t OFF_Z = OFF_Y + (size_t)TOK * 1024 * 2;
constexpr size_t OFF_X1B = OFF_Z;
constexpr size_t OFF_PART = OFF_X1B + (size_t)TOK * 1024 * 2;
constexpr size_t OFF_CNT = OFF_PART + (size_t)2 * 64 * 4 * 256 * 8;
constexpr size_t OFF_BAR = OFF_CNT + 1024;
constexpr size_t WS_END = OFF_Z + (size_t)TOK * 1024 * 4;

constexpr int LDS_BYTES = 131072;

struct Params {
    const float* x; const float* c; const int* pos; const float* ada_w; const float* ada_b; const float* ln_g; const float* ln_b;
    const float* ev_w_in; const float* ev_w_out; const float* ev_sink; const float* sg_ln_g; const float* sg_ln_b; const float* sg_w; const float* sg_b;
    const float* od_w_in; const float* conv_w; const float* conv_b; const float* w_a; const float* b_a; const float* w_x; const float* b_x; const float* lam; const float* od_w_out;
    float* out; unsigned char* ws;
};

__device__ __forceinline__ bf16_t f2bf(float f) { unsigned u = __float_as_uint(f); u += 0x7fffu + ((u >> 16) & 1u); return (bf16_t)(u >> 16); }
__device__ __forceinline__ float bf2f(bf16_t h) { return __uint_as_float(((unsigned)h) << 16); }
__device__ __forceinline__ unsigned pack2(float lo, float hi) { return (unsigned)f2bf(lo) | ((unsigned)f2bf(hi) << 16); }
__device__ __forceinline__ float lo2f(unsigned u) { return __uint_as_float(u << 16); }
__device__ __forceinline__ float hi2f(unsigned u) { return __uint_as_float(u & 0xffff0000u); }
__device__ __forceinline__ float sigmoid_f(float v) { return __builtin_amdgcn_rcpf(1.f + __builtin_amdgcn_exp2f(-1.4426950408889634f * v)); }
__device__ __forceinline__ float silu_f(float v) { return v * sigmoid_f(v); }
__device__ __forceinline__ int tid_fresh() { int t = threadIdx.x; asm volatile("" : "+v"(t)); return t; }

__device__ void transpose_tile(const float* __restrict__ src, int src_ld, bf16_t* __restrict__ dst, int dst_ld, int k0, int n0, float* tile) {
    const int tid = tid_fresh();
#pragma unroll
    for (int e = 0; e < 8; ++e) { int idx = tid + e * 512; int r = idx >> 6, cc = idx & 63; tile[r * 65 + cc] = src[(size_t)(k0 + r) * src_ld + n0 + cc]; }
    __syncthreads();
#pragma unroll
    for (int e = 0; e < 8; ++e) { int idx = tid + e * 512; int n = idx >> 6, k = idx & 63; dst[(size_t)(n0 + n) * dst_ld + k0 + k] = f2bf(tile[k * 65 + n]); }
    __syncthreads();
}

__device__ void transpose_job(const Params& p, int t, float* fs) {
    constexpr int J1 = 704, J2 = J1 + 256, J3 = J2 + 512, J4 = J3 + 256, J5 = J4 + 64, J6 = J5 + 64;
    const int tid = tid_fresh();
    if (t < J1) { int j = t; transpose_tile(p.ev_w_in, 2816, (bf16_t*)(p.ws + OFF_WINT), 1024, (j / 44) * 64, (j % 44) * 64, fs); }
    else if (t < J2) { int j = t - J1; transpose_tile(p.ev_w_out, 1024, (bf16_t*)(p.ws + OFF_WOUTT), 1024, (j / 16) * 64, (j % 16) * 64, fs); }
    else if (t < J3) { int j = t - J2; transpose_tile(p.od_w_in, 2048, (bf16_t*)(p.ws + OFF_OWINT), 1024, (j / 32) * 64, (j % 32) * 64, fs); }
    else if (t < J4) { int j = t - J3; transpose_tile(p.od_w_out, 1024, (bf16_t*)(p.ws + OFF_OWOUTT), 1024, (j / 16) * 64, (j % 16) * 64, fs); }
    else if (t < J5) { int j = t - J4; int m = j >> 2, q = j & 3; transpose_tile(p.w_a + (size_t)m * 16384, 128, (bf16_t*)(p.ws + OFF_WAT) + (size_t)m * 16384, 128, (q >> 1) * 64, (q & 1) * 64, fs); }
    else if (t < J6) { int j = t - J5; int m = j >> 2, q = j & 3; transpose_tile(p.w_x + (size_t)m * 16384, 128, (bf16_t*)(p.ws + OFF_WXT) + (size_t)m * 16384, 128, (q >> 1) * 64, (q & 1) * 64, fs); }
    else { int j = t - J6; bf16_t* d = (bf16_t*)(p.ws + OFF_SGW);
#pragma unroll
        for (int e = 0; e < 8; ++e) { int idx = j * 4096 + e * 512 + tid; d[idx] = f2bf(p.sg_w[idx]); } }
}

__device__ void phase0(const Params& p, unsigned char* smem) {
    const int tid = tid_fresh();
    float* fs = (float*)smem;
    constexpr int NJOBS = 1888, NMOD = 96;
    for (int it = blockIdx.x; it < NMOD; it += gridDim.x) {
        float* sc = fs; float* red = fs + 4096;
        for (int i = tid; i < 4096; i += 512) { float v = p.c[i]; sc[i] = silu_f(v); }
        __syncthreads();
        const int l = it / 48, n0 = (it % 48) * 64, w = tid >> 6, lane = tid & 63;
        const float* W = p.ada_w + (size_t)l * 1024 * 3072 + n0 + lane;
        float a0 = 0.f, a1 = 0.f, a2 = 0.f, a3 = 0.f;
        for (int k0 = w * 128; k0 < w * 128 + 128; k0 += 16) {
            float wv[16];
#pragma unroll
            for (int j = 0; j < 16; ++j) wv[j] = W[(size_t)(k0 + j) * 3072];
#pragma unroll
            for (int j = 0; j < 16; ++j) { a0 += sc[k0 + j] * wv[j]; a1 += sc[1024 + k0 + j] * wv[j]; a2 += sc[2048 + k0 + j] * wv[j]; a3 += sc[3072 + k0 + j] * wv[j]; }
        }
        red[(w * 4 + 0) * 64 + lane] = a0; red[(w * 4 + 1) * 64 + lane] = a1; red[(w * 4 + 2) * 64 + lane] = a2; red[(w * 4 + 3) * 64 + lane] = a3;
        __syncthreads();
        if (tid < 256) { int b = tid >> 6; float s = 0.f; for (int w2 = 0; w2 < 8; ++w2) s += red[(w2 * 4 + b) * 64 + lane];
            ((float*)(p.ws + OFF_MOD))[(l * 4 + b) * 3072 + n0 + lane] = s + p.ada_b[l * 3072 + n0 + lane]; }
        __syncthreads();
    }
    if (blockIdx.x == 0 && tid < 128) ((unsigned*)(p.ws + OFF_CNT))[tid] = 0u;
    const int G = gridDim.x, bid = blockIdx.x;
    if (G > 2 * NMOD) {
        if (bid < NMOD) transpose_job(p, bid, fs);
        else for (int t = NMOD + (bid - NMOD); t < NJOBS; t += G - NMOD) transpose_job(p, t, fs);
    } else {
        for (int t = bid; t < NJOBS; t += G) transpose_job(p, t, fs);
    }
}

__device__ void phase_modulate(const Params& p) {
    const float* mod = (const float*)(p.ws + OFF_MOD);
    bf16_t* h = (bf16_t*)(p.ws + OFF_H);
    const int tid = tid_fresh();
    for (int i = blockIdx.x * 512 + tid; i < TOK * 128; i += gridDim.x * 512) {
        const int row = i >> 7, col = (i & 127) * 8, b = row >> 12;
        const float* xr = p.x + (size_t)row * 1024 + col;
        f32x4 v0 = *(const f32x4*)xr, v1 = *(const f32x4*)(xr + 4);
        const float* sh = mod + b * 3072 + col; const float* scl = sh + 1024;
        f32x4 s0 = *(const f32x4*)sh, s1 = *(const f32x4*)(sh + 4), c0 = *(const f32x4*)scl, c1 = *(const f32x4*)(scl + 4);
#ifdef DBG_NOMOD
        s0 = s1 = c0 = c1 = (f32x4){0.f, 0.f, 0.f, 0.f};
#endif
        u32x4 o;
        o[0] = pack2(v0[0] * (1.f + c0[0]) + s0[0], v0[1] * (1.f + c0[1]) + s0[1]);
        o[1] = pack2(v0[2] * (1.f + c0[2]) + s0[2], v0[3] * (1.f + c0[3]) + s0[3]);
        o[2] = pack2(v1[0] * (1.f + c1[0]) + s1[0], v1[1] * (1.f + c1[1]) + s1[1]);
        o[3] = pack2(v1[2] * (1.f + c1[2]) + s1[2], v1[3] * (1.f + c1[3]) + s1[3]);
        *(u32x4*)(h + (size_t)row * 1024 + col) = o;
    }
}

constexpr int GBM = 256, GBK = 64, GHALF = 128, GHT = GHALF * GBK, GK = 1024;
__device__ __forceinline__ int lds_byte(int r, int c) { int st = (r >> 4) * 2 + (c >> 5), rr = r & 15, cc = c & 31, ob = rr * 64 + cc * 2; return st * 1024 + (ob ^ (((ob >> 9) & 1) << 5)); }
__device__ __forceinline__ void stage_rc(int b, int& R, int& C) { int st = b / 1024, sb = b % 1024, swz = sb ^ (((sb >> 9) & 1) << 5); R = (st >> 1) * 16 + swz / 64; C = (st & 1) * 32 + (swz % 64) / 2; }

template <class Epi>
__device__ __forceinline__ void gemm_tile(const bf16_t* __restrict__ A, const bf16_t* __restrict__ Bt, const int brow, const int bcol, LAS unsigned char* shm, const Epi& epi) {
#define SA(b, h) (shm + ((b) * 2 + (h)) * (GHT * 2))
#define SB(b, h) (shm + (4 + (b) * 2 + (h)) * (GHT * 2))
#define STAGE(P, BASE, br, kt) do { const char* _gb = (const char*)(BASE) + ((long)(br) * GK + (long)(kt) * GBK) * 2; \
    _Pragma("unroll") for (int _i = 0; _i < 2; ++_i) { \
      __builtin_amdgcn_global_load_lds((const unsigned*)(_gb + voff[_i]), (LAS unsigned*)((P) + ldsw + _i * 8192), 16, 0, 0); } } while (0)
#define LDA(dst, b, h) do { _Pragma("unroll") for (int m = 0; m < 4; ++m) _Pragma("unroll") for (int k = 0; k < 2; ++k) \
    dst[m][k] = *(const LAS bf16x8*)(SA(b, h) + aoff + m * 2048 + k * 1024); } while (0)
#define LDB(dst, b, h) do { _Pragma("unroll") for (int n = 0; n < 2; ++n) _Pragma("unroll") for (int k = 0; k < 2; ++k) \
    dst[n][k] = *(const LAS bf16x8*)(SB(b, h) + boff + n * 2048 + k * 1024); } while (0)
#define MMA(ai, bj, At_, Bt_) do { __builtin_amdgcn_s_setprio(1); \
    _Pragma("unroll") for (int m = 0; m < 4; ++m) _Pragma("unroll") for (int n = 0; n < 2; ++n) _Pragma("unroll") for (int k = 0; k < 2; ++k) \
      acc[ai][bj][m][n] = __builtin_amdgcn_mfma_f32_16x16x32_bf16(Bt_[n][k], At_[m][k], acc[ai][bj][m][n], 0, 0, 0); \
    __builtin_amdgcn_s_setprio(0); } while (0)
#define WAIT_V(n) asm volatile("s_waitcnt vmcnt(" #n ")" ::: "memory")
#define WAIT_L(n) asm volatile("s_waitcnt lgkmcnt(" #n ")" ::: "memory")
#define BAR __builtin_amdgcn_s_barrier()
#define SCHED __builtin_amdgcn_sched_barrier(0)
    const int tidx = tid_fresh();
    const int wid = tidx >> 6, lane = tidx & 63, wr = wid >> 2, wc = wid & 3, fr = lane & 15, fq = lane >> 4;
    const int aoff = lds_byte(wr * 64 + fr, fq * 8), boff = lds_byte(wc * 32 + fr, fq * 8), ldsw = tidx * 16;
    int voff[2];
#pragma unroll
    for (int i = 0; i < 2; ++i) { int r_, c_; stage_rc(tidx * 16 + i * 8192, r_, c_); voff[i] = (r_ * GK + c_) * 2; }
    f32x4 acc[2][2][4][2];
#pragma unroll
    for (int a = 0; a < 2; ++a)
#pragma unroll
        for (int b = 0; b < 2; ++b)
#pragma unroll
            for (int m = 0; m < 4; ++m)
#pragma unroll
                for (int n = 0; n < 2; ++n) acc[a][b][m][n] = (f32x4){0.f, 0.f, 0.f, 0.f};
    bf16x8 At[4][2], B0[2][2], B1[2][2];
    constexpr int nt = GK / GBK;
    STAGE(SB(0, 0), Bt, bcol, 0); STAGE(SA(0, 0), A, brow, 0);
    STAGE(SB(0, 1), Bt, bcol + GHALF, 0); STAGE(SA(0, 1), A, brow + GHALF, 0);
    if (wr == 1) BAR;
    WAIT_V(4); BAR;
    STAGE(SB(1, 0), Bt, bcol, 1); STAGE(SA(1, 0), A, brow, 1); STAGE(SB(1, 1), Bt, bcol + GHALF, 1);
    WAIT_V(6); BAR;
    for (int t = 0; t < nt - 2; t += 2) {
        LDB(B0, 0, 0); SCHED; LDA(At, 0, 0); STAGE(SA(1, 1), A, brow + GHALF, t + 1);
        WAIT_L(8); BAR; WAIT_L(0); MMA(0, 0, At, B0); BAR; SCHED;
        LDB(B1, 0, 1); STAGE(SB(0, 0), Bt, bcol, t + 2);
        BAR; WAIT_L(0); MMA(0, 1, At, B1); BAR;
        LDA(At, 0, 1); STAGE(SA(0, 0), A, brow, t + 2);
        BAR; WAIT_L(0); MMA(1, 0, At, B0); BAR; SCHED;
        STAGE(SB(0, 1), Bt, bcol + GHALF, t + 2);
        WAIT_V(6); BAR; MMA(1, 1, At, B1); BAR;
        LDB(B0, 1, 0); SCHED; LDA(At, 1, 0); STAGE(SA(0, 1), A, brow + GHALF, t + 2);
        WAIT_L(8); BAR; WAIT_L(0); MMA(0, 0, At, B0); BAR; SCHED;
        LDB(B1, 1, 1); STAGE(SB(1, 0), Bt, bcol, t + 3);
        BAR; WAIT_L(0); MMA(0, 1, At, B1); BAR;
        LDA(At, 1, 1); STAGE(SA(1, 0), A, brow, t + 3);
        BAR; WAIT_L(0); MMA(1, 0, At, B0); BAR; SCHED;
        STAGE(SB(1, 1), Bt, bcol + GHALF, t + 3);
        WAIT_V(6); BAR; MMA(1, 1, At, B1); BAR;
    }
    { LDB(B0, 0, 0); LDA(At, 0, 0); STAGE(SA(1, 1), A, brow + GHALF, nt - 1);
      BAR; WAIT_L(0); MMA(0, 0, At, B0); BAR;
      LDB(B1, 0, 1); BAR; WAIT_L(0); MMA(0, 1, At, B1); BAR;
      LDA(At, 0, 1); WAIT_V(4); BAR; WAIT_L(0); MMA(1, 0, At, B0); MMA(1, 1, At, B1); BAR; }
    { LDB(B0, 1, 0); LDA(At, 1, 0); WAIT_V(2); BAR; WAIT_L(0); MMA(0, 0, At, B0); BAR;
      LDB(B1, 1, 1); WAIT_V(0); BAR; WAIT_L(0); MMA(0, 1, At, B1); BAR;
      LDA(At, 1, 1); BAR; WAIT_L(0); MMA(1, 0, At, B0); MMA(1, 1, At, B1); BAR; }
    if (wr == 0) BAR;
    epi(acc, brow, bcol, wr, wc, fr, fq, shm);
    __syncthreads();
#undef SA
#undef SB
#undef STAGE
#undef LDA
#undef LDB
#undef MMA
}

template <class Epi>
__device__ __forceinline__ void gemm_phase(const bf16_t* A, const bf16_t* Bt, int N, LAS unsigned char* shm, const Epi& epi) {
    const int nM = TOK / GBM, nN = N / GBM, nwg = nM * nN;
    for (int L = blockIdx.x; L < nwg; L += gridDim.x) {
        int wgid = L; { const int q = nwg / 8, r = nwg % 8, xcd = wgid % 8, off = wgid / 8; wgid = (xcd < r ? xcd * (q + 1) : r * (q + 1) + (xcd - r) * q) + off; }
        const int nig = 8 * nN, gid = wgid / nig, fm = gid * 8, gsz = (nM - fm) < 8 ? (nM - fm) : 8;
        const int pm = fm + ((wgid % nig) % gsz), pn = (wgid % nig) / gsz;
        gemm_tile(A, Bt, pm * GBM, pn * GBM, shm, epi);
    }
}

struct EpiProj0 {
    bf16_t* O; const int* pos;
    __device__ __forceinline__ void operator()(f32x4 (&acc)[2][2][4][2], int brow, int bcol, int wr, int wc, int fr, int fq, LAS unsigned char*) const {
#pragma unroll
        for (int ai = 0; ai < 2; ++ai)
#pragma unroll
            for (int m = 0; m < 4; ++m) {
                const int row = brow + ai * 128 + wr * 64 + m * 16 + fr;
                const float posf = (float)pos[row];
#pragma unroll
                for (int bj = 0; bj < 2; ++bj)
#pragma unroll
                    for (int n = 0; n < 2; ++n) {
                        const int ctile = bcol + bj * 128 + wc * 32 + n * 16;
                        f32x4 v = acc[ai][bj][m][n];
                        if (ctile < 640 && (ctile & 63) == 0) {
#pragma unroll
                            for (int r = 0; r < 4; ++r) {
                                const float partner = __shfl_xor(v[r], 32);
                                const int i = (fq & 1) * 4 + r;
                                const float invf = exp2f(-(float)i * 2.3664460711655218f);
                                const float ang = posf * invf;
                                const float kf = rintf(ang * 0.15915494309189535f);
                                float red = fmaf(-kf, 6.28318548202514648f, ang);
                                red = fmaf(kf, 1.7484556e-7f, red);
                                const float sn = __sinf(red), cs = __cosf(red);
                                v[r] = (fq < 2) ? (v[r] * cs - partner * sn) : (v[r] * cs + partner * sn);
                            }
                        }
                        if (ctile < 512) { v[0] *= 0.125f; v[1] *= 0.125f; v[2] *= 0.125f; v[3] *= 0.125f; }
                        u32x2 o; o[0] = pack2(v[0], v[1]); o[1] = pack2(v[2], v[3]);
                        *(u32x2*)(O + (size_t)row * EW + ctile + fq * 4) = o;
                    }
            }
    }
};
struct EpiBf16 {
    bf16_t* O; int ld;
    __device__ __forceinline__ void operator()(f32x4 (&acc)[2][2][4][2], int brow, int bcol, int wr, int wc, int fr, int fq, LAS unsigned char*) const {
#pragma unroll
        for (int ai = 0; ai < 2; ++ai)
#pragma unroll
            for (int m = 0; m < 4; ++m) {
                const int row = brow + ai * 128 + wr * 64 + m * 16 + fr;
#pragma unroll
                for (int bj = 0; bj < 2; ++bj)
#pragma unroll
                    for (int n = 0; n < 2; ++n) {
                        const int col = bcol + bj * 128 + wc * 32 + n * 16 + fq * 4;
                        f32x4 v = acc[ai][bj][m][n];
                        u32x2 o; o[0] = pack2(v[0], v[1]); o[1] = pack2(v[2], v[3]);
                        *(u32x2*)(O + (size_t)row * ld + col) = o;
                    }
            }
    }
};
struct EpiRes {
    float* Z; const float* X; const float* gate;
    __device__ __forceinline__ void operator()(f32x4 (&acc)[2][2][4][2], int brow, int bcol, int wr, int wc, int fr, int fq, LAS unsigned char*) const {
#pragma unroll
        for (int ai = 0; ai < 2; ++ai)
#pragma unroll
            for (int m = 0; m < 4; ++m) {
                const int row = brow + ai * 128 + wr * 64 + m * 16 + fr;
                const int b = row >> 12;
#pragma unroll
                for (int bj = 0; bj < 2; ++bj)
#pragma unroll
                    for (int n = 0; n < 2; ++n) {
                        const int col = bcol + bj * 128 + wc * 32 + n * 16 + fq * 4;
                        const f32x4 xv = *(const f32x4*)(X + (size_t)row * 1024 + col);
                        const f32x4 gv = *(const f32x4*)(gate + b * 3072 + col);
                        *(f32x4*)(Z + (size_t)row * 1024 + col) = ALPHA * xv + gv * acc[ai][bj][m][n];
                    }
            }
    }
};

struct EpiLn {
    const float* X32; const bf16_t* X16;
    const float* gate;
    const float* lng; const float* lnb;
    const float* modn;
    float* out32; bf16_t* x1b; bf16_t* h1;
    unsigned long long* part;
    unsigned* cnt;
    __device__ __forceinline__ void operator()(f32x4 (&acc)[2][2][4][2], int brow, int bcol, int wr, int wc, int fr, int fq, LAS unsigned char* shm) const {
        LAS float* red = (LAS float*)shm;
        LAS float* stat = (LAS float*)(shm + 8192);
        const int pm = brow >> 8, pn = bcol >> 8, tid = (wr * 4 + wc) * 64 + fq * 16 + fr;
#pragma unroll
        for (int ai = 0; ai < 2; ++ai)
#pragma unroll
            for (int m = 0; m < 4; ++m) {
                const int rl = ai * 128 + wr * 64 + m * 16 + fr, row = brow + rl, b = row >> 12;
                float s1 = 0.f, s2 = 0.f;
#pragma unroll
                for (int bj = 0; bj < 2; ++bj)
#pragma unroll
                    for (int n = 0; n < 2; ++n) {
                        const int col = bcol + bj * 128 + wc * 32 + n * 16 + fq * 4;
                        f32x4 xv;
                        if (X32) xv = *(const f32x4*)(X32 + (size_t)row * 1024 + col);
                        else { const u32x2 xu = *(const u32x2*)(X16 + (size_t)row * 1024 + col); xv[0] = lo2f(xu[0]); xv[1] = hi2f(xu[0]); xv[2] = lo2f(xu[1]); xv[3] = hi2f(xu[1]); }
                        const f32x4 gv = *(const f32x4*)(gate + b * 3072 + col);
                        const f32x4 z = ALPHA * xv + gv * acc[ai][bj][m][n];
                        acc[ai][bj][m][n] = z;
                        s1 += z[0] + z[1] + z[2] + z[3];
                        s2 += z[0] * z[0] + z[1] * z[1] + z[2] * z[2] + z[3] * z[3];
                    }
                s1 += __shfl_xor(s1, 16); s1 += __shfl_xor(s1, 32);
                s2 += __shfl_xor(s2, 16); s2 += __shfl_xor(s2, 32);
                if (fq == 0) { red[(rl * 4 + wc) * 2] = s1; red[(rl * 4 + wc) * 2 + 1] = s2; }
            }
        __syncthreads();
        if (tid < 256) {
            float S1 = 0.f, S2 = 0.f;
#pragma unroll
            for (int q = 0; q < 4; ++q) { S1 += red[(tid * 4 + q) * 2]; S2 += red[(tid * 4 + q) * 2 + 1]; }
            const unsigned long long v = (unsigned long long)__float_as_uint(S1) | ((unsigned long long)__float_as_uint(S2) << 32);
            __hip_atomic_store(part + (size_t)(pm * 4 + pn) * 256 + tid, v, __ATOMIC_RELAXED, __HIP_MEMORY_SCOPE_AGENT);
        }
        asm volatile("s_waitcnt vmcnt(0)" ::: "memory");
        __syncthreads();
        if (tid == 0) {
            __hip_atomic_fetch_add(cnt + pm, 1u, __ATOMIC_RELAXED, __HIP_MEMORY_SCOPE_AGENT);
            while (__hip_atomic_load(cnt + pm, __ATOMIC_RELAXED, __HIP_MEMORY_SCOPE_AGENT) < 4u) __builtin_amdgcn_s_sleep(1);
            __builtin_amdgcn_fence(__ATOMIC_ACQUIRE, "agent");
            asm volatile("s_waitcnt vmcnt(0)" ::: "memory");
        }
        __syncthreads();
        if (tid < 256) {
            float S1 = 0.f, S2 = 0.f;
#pragma unroll
            for (int q = 0; q < 4; ++q) {
                const unsigned long long v = __hip_atomic_load(part + (size_t)(pm * 4 + q) * 256 + tid, __ATOMIC_RELAXED, __HIP_MEMORY_SCOPE_AGENT);
                S1 += __uint_as_float((unsigned)v); S2 += __uint_as_float((unsigned)(v >> 32));
            }
            const float mu = S1 * (1.f / 1024.f);
            const float var = fmaxf(S2 * (1.f / 1024.f) - mu * mu, 0.f);
            stat[tid * 2] = mu; stat[tid * 2 + 1] = rsqrtf(var + 1e-5f);
        }
        __syncthreads();
#pragma unroll
        for (int ai = 0; ai < 2; ++ai)
#pragma unroll
            for (int m = 0; m < 4; ++m) {
                const int rl = ai * 128 + wr * 64 + m * 16 + fr, row = brow + rl, b = row >> 12;
                const float mu = stat[rl * 2], rs = stat[rl * 2 + 1];
#pragma unroll
                for (int bj = 0; bj < 2; ++bj)
#pragma unroll
                    for (int n = 0; n < 2; ++n) {
                        const int col = bcol + bj * 128 + wc * 32 + n * 16 + fq * 4;
                        const f32x4 gv = *(const f32x4*)(lng + col), bv = *(const f32x4*)(lnb + col);
                        f32x4 o;
#pragma unroll
                        for (int j = 0; j < 4; ++j) o[j] = (acc[ai][bj][m][n][j] - mu) * rs * gv[j] + bv[j];
                        if (out32) *(f32x4*)(out32 + (size_t)row * 1024 + col) = o;
                        if (x1b) { u32x2 u; u[0] = pack2(o[0], o[1]); u[1] = pack2(o[2], o[3]); *(u32x2*)(x1b + (size_t)row * 1024 + col) = u; }
                        if (h1) {
                            const f32x4 sh = *(const f32x4*)(modn + b * 3072 + col), sc = *(const f32x4*)(modn + b * 3072 + 1024 + col);
                            u32x2 u; u[0] = pack2(o[0] * (1.f + sc[0]) + sh[0], o[1] * (1.f + sc[1]) + sh[1]); u[1] = pack2(o[2] * (1.f + sc[2]) + sh[2], o[3] * (1.f + sc[3]) + sh[3]);
                            *(u32x2*)(h1 + (size_t)row * 1024 + col) = u;
                        }
                    }
            }
    }
};

constexpr int KS_LD = 72, VT_LD = 392;
__device__ void attn_item(const Params& p, int item, unsigned char* smem) {
    const bf16_t* proj = (const bf16_t*)(p.ws + OFF_PROJ);
    bf16_t* y = (bf16_t*)(p.ws + OFF_Y);
    const int b = item >> 6, n = (item >> 1) & 31, h = item & 1;
    const int tid = tid_fresh(), w = tid >> 6, lane = tid & 63, fr = lane & 15, fq = lane >> 4;
    bf16_t* Ks = (bf16_t*)smem;
    bf16_t* Vt = Ks + 384 * KS_LD;
    for (int e = tid; e < 384 * 8; e += 512) {
        const int kj = e >> 3, ch = e & 7;
        const int s = n * 128 - 128 + kj;
        u32x4 kv = {0u, 0u, 0u, 0u}, vv = {0u, 0u, 0u, 0u};
        if (s >= 0 && s < SEQ) {
            const bf16_t* row = proj + (size_t)(b * SEQ + s) * EW;
            kv = *(const u32x4*)(row + 512 + h * 64 + ch * 8);
            vv = *(const u32x4*)(row + 640 + h * 64 + ch * 8);
        }
        *(u32x4*)(Ks + kj * KS_LD + ch * 8) = kv;
#pragma unroll
        for (int j = 0; j < 8; ++j) Vt[(ch * 8 + j) * VT_LD + kj] = (bf16_t)(vv[j >> 1] >> ((j & 1) * 16));
    }
    __syncthreads();
    const int tok = b * SEQ + n * 128 + w * 16 + fr;
    for (int g = 0; g < 4; ++g) {
        const int qh = h * 4 + g;
        const bf16_t* qrow = proj + (size_t)tok * EW + qh * 64;
        const bf16x8 q0 = *(const bf16x8*)(qrow + fq * 8), q1 = *(const bf16x8*)(qrow + 32 + fq * 8);
        f32x4 S[17];
#pragma unroll
        for (int tt = 0; tt < 17; ++tt) {
            const bf16_t* kp = Ks + ((w + tt) * 16 + fr) * KS_LD + fq * 8;
            const bf16x8 k0 = *(const bf16x8*)kp, k1 = *(const bf16x8*)(kp + 32);
            f32x4 a = {0.f, 0.f, 0.f, 0.f};
            a = __builtin_amdgcn_mfma_f32_16x16x32_bf16(k0, q0, a, 0, 0, 0);
            a = __builtin_amdgcn_mfma_f32_16x16x32_bf16(k1, q1, a, 0, 0, 0);
            S[tt] = a;
            asm volatile("" ::: "memory");
        }
        const float sink = p.ev_sink[qh];
        float mx = sink;
#pragma unroll
        for (int tt = 0; tt < 17; ++tt)
#pragma unroll
            for (int r = 0; r < 4; ++r) {
                const int b16 = n * 8 - 8 + w + tt;
                float v = (b16 >= 0 && b16 < SEQ / 16) ? S[tt][r] : -1e30f;
                if (tt == 0) v = (fq * 4 + r >= fr) ? v : -1e30f;
                if (tt == 16) v = (fq * 4 + r <= fr) ? v : -1e30f;
                S[tt][r] = v; mx = fmaxf(mx, v);
            }
        mx = fmaxf(mx, __shfl_xor(mx, 16)); mx = fmaxf(mx, __shfl_xor(mx, 32));
        float sum = 0.f;
#pragma unroll
        for (int tt = 0; tt < 17; ++tt)
#pragma unroll
            for (int r = 0; r < 4; ++r) { const float e = __expf(S[tt][r] - mx); S[tt][r] = e; sum += e; }
        sum += __shfl_xor(sum, 16); sum += __shfl_xor(sum, 32);
        const float inv = 1.f / (sum + __expf(sink - mx));
        f32x4 O[4];
#pragma unroll
        for (int dt = 0; dt < 4; ++dt) O[dt] = (f32x4){0.f, 0.f, 0.f, 0.f};
#pragma unroll
        for (int pp = 0; pp < 8; ++pp) {
            const int t0 = 2 * pp, t1 = 2 * pp + 1;
            u32x4 pu; pu[0] = pack2(S[t0][0], S[t0][1]); pu[1] = pack2(S[t0][2], S[t0][3]); pu[2] = pack2(S[t1][0], S[t1][1]); pu[3] = pack2(S[t1][2], S[t1][3]);
            const bf16x8 pf = __builtin_bit_cast(bf16x8, pu);
#pragma unroll
            for (int dt = 0; dt < 4; ++dt) {
                const bf16_t* vp = Vt + (dt * 16 + fr) * VT_LD + (w + t0) * 16 + fq * 4;
                u32x4 vu; const u32x2 va = *(const u32x2*)vp, vb = *(const u32x2*)(vp + 16);
                vu[0] = va[0]; vu[1] = va[1]; vu[2] = vb[0]; vu[3] = vb[1];
                O[dt] = __builtin_amdgcn_mfma_f32_16x16x32_bf16(__builtin_bit_cast(bf16x8, vu), pf, O[dt], 0, 0, 0);
            }
            asm volatile("" ::: "memory");
        }
        {
            u32x2 pu; pu[0] = pack2(S[16][0], S[16][1]); pu[1] = pack2(S[16][2], S[16][3]);
            const bf16x4 pf = __builtin_bit_cast(bf16x4, pu);
#pragma unroll
            for (int dt = 0; dt < 4; ++dt) {
                const bf16x4 vf = *(const bf16x4*)(Vt + (dt * 16 + fr) * VT_LD + (w + 16) * 16 + fq * 4);
                O[dt] = __builtin_amdgcn_mfma_f32_16x16x16bf16_1k(vf, pf, O[dt], 0, 0, 0);
            }
        }
#pragma unroll
        for (int dt = 0; dt < 4; ++dt) {
            const int col = qh * 64 + dt * 16 + fq * 4;
            const u32x2 gu = *(const u32x2*)(proj + (size_t)tok * EW + 1792 + col);
            u32x2 o;
            o[0] = pack2(O[dt][0] * inv * silu_f(lo2f(gu[0])), O[dt][1] * inv * silu_f(hi2f(gu[0])));
            o[1] = pack2(O[dt][2] * inv * silu_f(lo2f(gu[1])), O[dt][3] * inv * silu_f(hi2f(gu[1])));
            *(u32x2*)(y + (size_t)tok * 1024 + col) = o;
        }
    }
    __syncthreads();
}

constexpr int VN_LD = 136;
__device__ void sg_item(const Params& p, int item, unsigned char* smem) {
    const bf16_t* proj = (const bf16_t*)(p.ws + OFF_PROJ);
    const bf16_t* sgw = (const bf16_t*)(p.ws + OFF_SGW);
    bf16_t* y = (bf16_t*)(p.ws + OFF_Y);
    const int b = item >> 8, c = (item >> 3) & 31, gi = item & 7;
    const int tid = tid_fresh(), w = tid >> 6, lane = tid & 63, fr = lane & 15, fq = lane >> 4;
    bf16_t* vnT = (bf16_t*)smem;
    const int tok0 = b * SEQ + c * 128;
    {
        const int q = tid >> 2, part = tid & 3;
        const bf16_t* src = proj + (size_t)(tok0 + q) * EW + 1280 + gi * 64 + part * 16;
        const u32x4 r0 = *(const u32x4*)src, r1 = *(const u32x4*)(src + 8);
        float v[16];
#pragma unroll
        for (int j = 0; j < 4; ++j) { v[2 * j] = lo2f(r0[j]); v[2 * j + 1] = hi2f(r0[j]); v[8 + 2 * j] = lo2f(r1[j]); v[8 + 2 * j + 1] = hi2f(r1[j]); }
        float s = 0.f;
#pragma unroll
        for (int j = 0; j < 16; ++j) s += v[j];
        s += __shfl_xor(s, 1); s += __shfl_xor(s, 2);
        const float mu = s * (1.f / 64.f);
        float ss = 0.f;
#pragma unroll
        for (int j = 0; j < 16; ++j) { const float d = v[j] - mu; ss += d * d; }
        ss += __shfl_xor(ss, 1); ss += __shfl_xor(ss, 2);
        const float rs = rsqrtf(ss * (1.f / 64.f) + 1e-5f);
#pragma unroll
        for (int j = 0; j < 16; ++j) {
            const int d = part * 16 + j;
            const float vn = (v[j] - mu) * rs * p.sg_ln_g[gi * 64 + d] + p.sg_ln_b[gi * 64 + d];
            vnT[d * VN_LD + q] = f2bf(vn);
        }
    }
    __syncthreads();
    const bf16_t* wrow = sgw + (size_t)(gi * 128 + w * 16 + fr) * 128 + fq * 8;
    bf16x8 wf[4];
#pragma unroll
    for (int kk = 0; kk < 4; ++kk) wf[kk] = *(const bf16x8*)(wrow + kk * 32);
    f32x4 acc[4];
#pragma unroll
    for (int dt = 0; dt < 4; ++dt) {
        acc[dt] = (f32x4){0.f, 0.f, 0.f, 0.f};
#pragma unroll
        for (int kk = 0; kk < 4; ++kk) {
            const bf16x8 vf = *(const bf16x8*)(vnT + (dt * 16 + fr) * VN_LD + kk * 32 + fq * 8);
            acc[dt] = __builtin_amdgcn_mfma_f32_16x16x32_bf16(vf, wf[kk], acc[dt], 0, 0, 0);
        }
    }
    const int prow = w * 16 + fr, tok = tok0 + prow;
    const float bs = p.sg_b[gi * 128 + prow];
#pragma unroll
    for (int dt = 0; dt < 4; ++dt) {
        const int col = gi * 64 + dt * 16 + fq * 4;
        const u32x2 su = *(const u32x2*)(proj + (size_t)tok * EW + 768 + col);
        const u32x2 gu = *(const u32x2*)(proj + (size_t)tok * EW + 1792 + 512 + col);
        u32x2 o;
        o[0] = pack2((acc[dt][0] + bs) * lo2f(su[0]) * silu_f(lo2f(gu[0])), (acc[dt][1] + bs) * hi2f(su[0]) * silu_f(hi2f(gu[0])));
        o[1] = pack2((acc[dt][2] + bs) * lo2f(su[1]) * silu_f(lo2f(gu[1])), (acc[dt][3] + bs) * hi2f(su[1]) * silu_f(hi2f(gu[1])));
        *(u32x2*)(y + (size_t)tok * 1024 + 512 + col) = o;
    }
    __syncthreads();
}

__device__ void ln_phase(const Params& p, const float* __restrict__ z, float* __restrict__ xo, bf16_t* __restrict__ ho, const float* g, const float* bb, const float* modn) {
    const int tid = tid_fresh();
    const int w = tid >> 6, lane = tid & 63;
    for (int row = blockIdx.x * 8 + w; row < TOK; row += gridDim.x * 8) {
        const float* zr = z + (size_t)row * 1024;
        f32x4 v[4];
#pragma unroll
        for (int i = 0; i < 4; ++i) v[i] = *(const f32x4*)(zr + i * 256 + lane * 4);
        float s = 0.f;
#pragma unroll
        for (int i = 0; i < 4; ++i) s += v[i][0] + v[i][1] + v[i][2] + v[i][3];
#pragma unroll
        for (int o = 32; o >= 1; o >>= 1) s += __shfl_xor(s, o);
        const float mu = s * (1.f / 1024.f);
        float ss = 0.f;
#pragma unroll
        for (int i = 0; i < 4; ++i)
#pragma unroll
            for (int j = 0; j < 4; ++j) { const float d = v[i][j] - mu; ss += d * d; }
#pragma unroll
        for (int o = 32; o >= 1; o >>= 1) ss += __shfl_xor(ss, o);
        const float rs = rsqrtf(ss * (1.f / 1024.f) + 1e-5f);
        const int b = row >> 12;
#pragma unroll
        for (int i = 0; i < 4; ++i) {
            const int col = i * 256 + lane * 4;
            const f32x4 gv = *(const f32x4*)(g + col), bv = *(const f32x4*)(bb + col);
            f32x4 o;
#pragma unroll
            for (int j = 0; j < 4; ++j) o[j] = (v[i][j] - mu) * rs * gv[j] + bv[j];
            *(f32x4*)(xo + (size_t)row * 1024 + col) = o;
            if (ho) {
                const f32x4 sh = *(const f32x4*)(modn + b * 3072 + col), sc = *(const f32x4*)(modn + b * 3072 + 1024 + col);
                u32x2 hu; hu[0] = pack2(o[0] * (1.f + sc[0]) + sh[0], o[1] * (1.f + sc[1]) + sh[1]); hu[1] = pack2(o[2] * (1.f + sc[2]) + sh[2], o[3] * (1.f + sc[3]) + sh[3]);
                *(u32x2*)(ho + (size_t)row * 1024 + col) = hu;
            }
        }
    }
}

constexpr int XC_LD = 136;
template <int PASS>
__device__ void lru_item(const Params& p, int item, unsigned char* smem) {
    const bf16_t* proj = (const bf16_t*)(p.ws + OFF_PROJ);
    float* sums = (float*)(p.ws + OFF_SUM);
    const int hd = item & 7, c = (item >> 3) & 31, b = item >> 8;
    const int tid = tid_fresh(), w = tid >> 6, lane = tid & 63, fr = lane & 15, fq = lane >> 4;
    bf16_t* Xc = (bf16_t*)smem;
    bf16_t* Ys = Xc + 128 * XC_LD;
    const int tok0 = b * SEQ + c * 128;
    float hcin0 = 0.f, hcin1 = 0.f;
    if (PASS == 2) {
        const int chl = hd * 128 + w * 16 + fr;
#pragma unroll
        for (int dir = 0; dir < 2; ++dir) {
            const float* As = sums + (size_t)(dir * 2 + 0) * (SUM_SZ / 4) + (size_t)(b * 32) * 1024 + chl;
            const float* Hs = sums + (size_t)(dir * 2 + 1) * (SUM_SZ / 4) + (size_t)(b * 32) * 1024 + chl;
            float Av[31], Hv[31];
#pragma unroll
            for (int i = 0; i < 31; ++i) { const int c2 = dir ? 31 - i : i; Av[i] = As[c2 * 1024]; Hv[i] = Hs[c2 * 1024]; }
            float hcv = 0.f;
#pragma unroll
            for (int i = 0; i < 31; ++i) { const int c2 = dir ? 31 - i : i; const bool valid = dir ? (c2 > c) : (c2 < c); hcv = valid ? (Av[i] * hcv + Hv[i]) : hcv; }
            if (dir) hcin1 = hcv; else hcin0 = hcv;
        }
        asm volatile("" ::: "memory");
    }
    {
        const int cg8 = tid & 15, tg = tid >> 4;
        const int ch0 = hd * 128 + cg8 * 8;
        float cw[4][8], cbv[8];
#pragma unroll
        for (int k = 0; k < 4; ++k) { const f32x4 a = *(const f32x4*)(p.conv_w + k * 1024 + ch0), bq = *(const f32x4*)(p.conv_w + k * 1024 + ch0 + 4);
#pragma unroll
            for (int j = 0; j < 4; ++j) { cw[k][j] = a[j]; cw[k][4 + j] = bq[j]; } }
        { const f32x4 a = *(const f32x4*)(p.conv_b + ch0), bq = *(const f32x4*)(p.conv_b + ch0 + 4);
#pragma unroll
            for (int j = 0; j < 4; ++j) { cbv[j] = a[j]; cbv[4 + j] = bq[j]; } }
        float xin[7][8];
#pragma unroll
        for (int i = 0; i < 7; ++i) {
            const int s = c * 128 + tg * 4 - 2 + i;
            u32x4 u = {0u, 0u, 0u, 0u};
            if (s >= 0 && s < SEQ) u = *(const u32x4*)(proj + (size_t)(b * SEQ + s) * OW + ch0);
#pragma unroll
            for (int j = 0; j < 4; ++j) { xin[i][2 * j] = lo2f(u[j]); xin[i][2 * j + 1] = hi2f(u[j]); }
        }
#pragma unroll
        for (int rr = 0; rr < 4; ++rr) {
            float o[8];
#pragma unroll
            for (int j = 0; j < 8; ++j) o[j] = cbv[j] + cw[0][j] * xin[rr][j] + cw[1][j] * xin[rr + 1][j] + cw[2][j] * xin[rr + 2][j] + cw[3][j] * xin[rr + 3][j];
            u32x4 ou; ou[0] = pack2(o[0], o[1]); ou[1] = pack2(o[2], o[3]); ou[2] = pack2(o[4], o[5]); ou[3] = pack2(o[6], o[7]);
            *(u32x4*)(Xc + (tg * 4 + rr) * XC_LD + cg8 * 8) = ou;
        }
    }
    __syncthreads();
    const int ch = hd * 128 + w * 16 + fr;
    float hf[8][4];
#pragma unroll
    for (int dir = 0; dir < 2; ++dir) {
        const bf16_t* wa_row = (const bf16_t*)(p.ws + OFF_WAT) + (size_t)((dir * 8 + hd) * 128 + w * 16 + fr) * 128 + fq * 8;
        const bf16_t* wx_row = (const bf16_t*)(p.ws + OFF_WXT) + (size_t)((dir * 8 + hd) * 128 + w * 16 + fr) * 128 + fq * 8;
        bf16x8 wa[4], wx[4];
#pragma unroll
        for (int kk = 0; kk < 4; ++kk) { wa[kk] = *(const bf16x8*)(wa_row + kk * 32); wx[kk] = *(const bf16x8*)(wx_row + kk * 32); }
        const float ba = p.b_a[dir * 1024 + ch], bx = p.b_x[dir * 1024 + ch];
        const float c8 = 8.f * 1.4426950408889634f * log1pf(__expf(-p.lam[dir * 1024 + ch]));
        const int fqt = dir ? 3 - fq : fq;
        const int src1 = (dir ? lane + 16 : lane - 16) & 63, src2 = (dir ? lane + 32 : lane - 32) & 63, lastl = dir ? fr : fr + 48;
        float hc = 0.f, Pc = 1.f;
        if (PASS == 2) hc = dir ? hcin1 : hcin0;
#pragma unroll
        for (int mi = 0; mi < 8; ++mi) {
            const int mt = dir ? 7 - mi : mi;
            f32x4 pr = {0.f, 0.f, 0.f, 0.f}, pi = {0.f, 0.f, 0.f, 0.f};
#pragma unroll
            for (int kk = 0; kk < 4; ++kk) {
                const bf16x8 xa = *(const bf16x8*)(Xc + (mt * 16 + fr) * XC_LD + kk * 32 + fq * 8);
                pr = __builtin_amdgcn_mfma_f32_16x16x32_bf16(xa, wa[kk], pr, 0, 0, 0);
                pi = __builtin_amdgcn_mfma_f32_16x16x32_bf16(xa, wx[kk], pi, 0, 0, 0);
            }
            float av[4], bv[4];
#pragma unroll
            for (int u = 0; u < 4; ++u) {
                const int r = dir ? 3 - u : u;
                const int t = mt * 16 + fq * 4 + r;
                const float xv = bf2f(Xc[t * XC_LD + w * 16 + fr]);
                const float rg = sigmoid_f(pr[r] + ba), ig = sigmoid_f(pi[r] + bx);
                const float a = __builtin_amdgcn_exp2f(-c8 * rg);
                av[u] = a;
                bv[u] = __builtin_amdgcn_sqrtf(fmaxf(fmaf(-a, a, 1.f), 0.f)) * ig * xv;
            }
            float Ap[4], Bp[4];
            Ap[0] = av[0]; Bp[0] = bv[0];
#pragma unroll
            for (int u = 1; u < 4; ++u) { Ap[u] = av[u] * Ap[u - 1]; Bp[u] = av[u] * Bp[u - 1] + bv[u]; }
            float IA = Ap[3], IB = Bp[3];
            { const float pa = __shfl(IA, src1), pb = __shfl(IB, src1); if (fqt >= 1) { IB = IA * pb + IB; IA = IA * pa; } }
            { const float pa = __shfl(IA, src2), pb = __shfl(IB, src2); if (fqt >= 2) { IB = IA * pb + IB; IA = IA * pa; } }
            if (PASS == 2) {
                float EA = __shfl(IA, src1), EB = __shfl(IB, src1);
                if (fqt == 0) { EA = 1.f; EB = 0.f; }
                const float hin = EA * hc + EB;
#pragma unroll
                for (int u = 0; u < 4; ++u) {
                    const int r = dir ? 3 - u : u;
                    const int t = mt * 16 + fq * 4 + r;
                    const float hv = Ap[u] * hin + Bp[u];
                    if (dir == 0) hf[mt][r] = hv;
                    else Ys[t * XC_LD + w * 16 + fr] = f2bf(hf[mt][r] + hv);
                }
            }
            const float TA = __shfl(IA, lastl), TB = __shfl(IB, lastl);
            hc = TA * hc + TB; Pc = TA * Pc;
            asm volatile("" ::: "memory");
        }
        if (PASS == 1 && fq == 0) { sums[(size_t)(dir * 2 + 0) * (SUM_SZ / 4) + (size_t)(b * 32 + c) * 1024 + ch] = Pc; sums[(size_t)(dir * 2 + 1) * (SUM_SZ / 4) + (size_t)(b * 32 + c) * 1024 + ch] = hc; }
    }
    if (PASS == 2) {
        bf16_t* y = (bf16_t*)(p.ws + OFF_Y);
        __syncthreads();
#pragma unroll
        for (int e = 0; e < 4; ++e) {
            const int idx = tid + e * 512, t = idx >> 4, ck = idx & 15;
            const u32x4 yu = *(const u32x4*)(Ys + t * XC_LD + ck * 8);
            const u32x4 gu = *(const u32x4*)(proj + (size_t)(tok0 + t) * OW + 1024 + hd * 128 + ck * 8);
            u32x4 ou;
#pragma unroll
            for (int j = 0; j < 4; ++j) ou[j] = pack2(lo2f(yu[j]) * silu_f(lo2f(gu[j])), hi2f(yu[j]) * silu_f(hi2f(gu[j])));
            *(u32x4*)(y + (size_t)(tok0 + t) * 1024 + hd * 128 + ck * 8) = ou;
        }
    }
    __syncthreads();
}

#ifdef DBG_STOP
#ifndef DBG_COL
#define DBG_COL 0
#endif
__device__ void dbg_copy_f32(const Params& p, const float* src) {
    for (int i = blockIdx.x * 512 + threadIdx.x; i < TOK * 256; i += gridDim.x * 512) ((f32x4*)p.out)[i] = ((const f32x4*)src)[i];
}
__device__ void dbg_copy_bf16(const Params& p, const bf16_t* src, int ld, int coloff) {
    for (int i = blockIdx.x * 512 + threadIdx.x; i < TOK * 1024; i += gridDim.x * 512) { int row = i >> 10, col = i & 1023; p.out[i] = bf2f(src[(size_t)row * ld + coloff + col]); }
}
#define DBG_AT(k, stmt) if (DBG_STOP == k) { stmt; return; }
#else
#define DBG_AT(k, stmt)
#endif
__device__ unsigned g_bar = 0;
__device__ __forceinline__ void gsync(cg::grid_group& g, unsigned* bar, unsigned& epoch) {
    (void)g; (void)bar; (void)epoch;
    asm volatile("s_waitcnt vmcnt(0) lgkmcnt(0)" ::: "memory");
    __syncthreads();
    if (threadIdx.x == 0) {
        __builtin_amdgcn_fence(__ATOMIC_RELEASE, "agent");
        asm volatile("s_waitcnt vmcnt(0)" ::: "memory");
        const unsigned nb = gridDim.x;
        const unsigned old = __hip_atomic_fetch_add(&g_bar, 1u, __ATOMIC_RELAXED, __HIP_MEMORY_SCOPE_AGENT);
        const unsigned gen = old & 0xffff0000u;
        if ((old & 0xffffu) == nb - 1u) __hip_atomic_fetch_add(&g_bar, 0x10000u - nb, __ATOMIC_RELAXED, __HIP_MEMORY_SCOPE_AGENT);
        else while ((__hip_atomic_load(&g_bar, __ATOMIC_RELAXED, __HIP_MEMORY_SCOPE_AGENT) & 0xffff0000u) == gen) __builtin_amdgcn_s_sleep(1);
        __builtin_amdgcn_fence(__ATOMIC_ACQUIRE, "agent");
        asm volatile("s_waitcnt vmcnt(0)" ::: "memory");
    }
    __syncthreads();
}

__global__ void __launch_bounds__(512) fwd_megakernel(Params p) {
    extern __shared__ __attribute__((aligned(16))) unsigned char shm[];
    cg::grid_group grid = cg::this_grid();
    LAS unsigned char* lshm = (LAS unsigned char*)shm;
    const float* mod = (const float*)(p.ws + OFF_MOD);
    unsigned* bar = (unsigned*)(p.ws + OFF_BAR);
    unsigned epoch = 0;
    DBG_AT(-1, dbg_copy_f32(p, p.x))
    grid.sync();

    for (int rep_ = 0; rep_ < (((REP_MASK) >> 0) & 1) + 1; ++rep_) {
    if (rep_) gsync(grid, bar, epoch);
    phase0(p, shm);
    }
    gsync(grid, bar, epoch);
    DBG_AT(0, dbg_copy_f32(p, (const float*)(p.ws + OFF_MOD - (size_t)0)))
    for (int rep_ = 0; rep_ < (((REP_MASK) >> 1) & 1) + 1; ++rep_) {
    if (rep_) gsync(grid, bar, epoch);
    phase_modulate(p);
    }
    gsync(grid, bar, epoch);
    DBG_AT(1, dbg_copy_bf16(p, (const bf16_t*)(p.ws + OFF_H), 1024, 0))
    for (int rep_ = 0; rep_ < (((REP_MASK) >> 2) & 1) + 1; ++rep_) {
    if (rep_) gsync(grid, bar, epoch);
    { EpiProj0 e{(bf16_t*)(p.ws + OFF_PROJ), p.pos}; gemm_phase((const bf16_t*)(p.ws + OFF_H), (const bf16_t*)(p.ws + OFF_WINT), EW, lshm, e); }
    }
    gsync(grid, bar, epoch);
    DBG_AT(2, dbg_copy_bf16(p, (const bf16_t*)(p.ws + OFF_PROJ), EW, DBG_COL))
    for (int rep_ = 0; rep_ < (((REP_MASK) >> 3) & 1) + 1; ++rep_) {
    if (rep_) gsync(grid, bar, epoch);
    for (int it = blockIdx.x; it < 256; it += gridDim.x) attn_item(p, it, shm);
    for (int it = blockIdx.x; it < 1024; it += gridDim.x) sg_item(p, it, shm);
    }
    gsync(grid, bar, epoch);
    DBG_AT(3, dbg_copy_bf16(p, (const bf16_t*)(p.ws + OFF_Y), 1024, 0))
    for (int rep_ = 0; rep_ < 1; ++rep_) {
    if (rep_) gsync(grid, bar, epoch);
    { EpiLn e{p.x, nullptr, mod + 2048, p.ln_g, p.ln_b, mod + 4 * 3072, nullptr, (bf16_t*)(p.ws + OFF_X1B), (bf16_t*)(p.ws + OFF_H), (unsigned long long*)(p.ws + OFF_PART), (unsigned*)(p.ws + OFF_CNT)};
      gemm_phase((const bf16_t*)(p.ws + OFF_Y), (const bf16_t*)(p.ws + OFF_WOUTT), 1024, lshm, e); }
    }
    gsync(grid, bar, epoch);
    DBG_AT(4, dbg_copy_f32(p, (const float*)(p.ws + OFF_Z)))
    for (int rep_ = 0; rep_ < (((REP_MASK) >> 6) & 1) + 1; ++rep_) {
    if (rep_) gsync(grid, bar, epoch);
    { EpiBf16 e{(bf16_t*)(p.ws + OFF_PROJ), OW}; gemm_phase((const bf16_t*)(p.ws + OFF_H), (const bf16_t*)(p.ws + OFF_OWINT), OW, lshm, e); }
    }
    gsync(grid, bar, epoch);
    DBG_AT(6, dbg_copy_bf16(p, (const bf16_t*)(p.ws + OFF_PROJ), OW, DBG_COL))
    for (int rep_ = 0; rep_ < (((REP_MASK) >> 7) & 1) + 1; ++rep_) {
    if (rep_) gsync(grid, bar, epoch);
    for (int it = blockIdx.x; it < 1024; it += gridDim.x) lru_item<1>(p, it, shm);
    }
    gsync(grid, bar, epoch);
    DBG_AT(7, dbg_copy_bf16(p, (const bf16_t*)(p.ws + OFF_Z), 1024, 0))
    for (int rep_ = 0; rep_ < (((REP_MASK) >> 8) & 1) + 1; ++rep_) {
    if (rep_) gsync(grid, bar, epoch);
    for (int it = blockIdx.x; it < 1024; it += gridDim.x) lru_item<2>(p, it, shm);
    }
    gsync(grid, bar, epoch);
    DBG_AT(8, dbg_copy_bf16(p, (const bf16_t*)(p.ws + OFF_Y), 1024, 0))
    for (int rep_ = 0; rep_ < 1; ++rep_) {
    if (rep_) gsync(grid, bar, epoch);
    { EpiLn e{nullptr, (const bf16_t*)(p.ws + OFF_X1B), mod + 4 * 3072 + 2048, p.ln_g + 1024, p.ln_b + 1024, nullptr, p.out, nullptr, nullptr, (unsigned long long*)(p.ws + OFF_PART) + 64 * 4 * 256, (unsigned*)(p.ws + OFF_CNT) + 64};
      gemm_phase((const bf16_t*)(p.ws + OFF_Y), (const bf16_t*)(p.ws + OFF_OWOUTT), 1024, lshm, e); }
    }
}

extern "C" void kernel_launch(void* const* d_in, const int* in_sizes, int n_in, void* d_out, int out_size, void* d_ws, size_t ws_size, hipStream_t stream) {
    static int grid_blocks = 0;
    if (grid_blocks == 0) {
        if (ws_size < WS_END) { fprintf(stderr, "kernel_launch: workspace too small (%zu < %zu)\n", ws_size, (size_t)WS_END); grid_blocks = -1; return; }
        int dev = 0, cus = 0, per_cu = 0;
        hipGetDevice(&dev);
        hipDeviceGetAttribute(&cus, hipDeviceAttributeMultiprocessorCount, dev);
        if (hipFuncSetAttribute((const void*)fwd_megakernel, hipFuncAttributeMaxDynamicSharedMemorySize, LDS_BYTES) != hipSuccess) { fprintf(stderr, "kernel_launch: hipFuncSetAttribute failed\n"); grid_blocks = -1; return; }
        if (hipOccupancyMaxActiveBlocksPerMultiprocessor(&per_cu, (const void*)fwd_megakernel, 512, LDS_BYTES) != hipSuccess || per_cu < 1) { fprintf(stderr, "kernel_launch: occupancy query failed (%d)\n", per_cu); per_cu = 1; (void)hipGetLastError(); }
        if (per_cu > 1) per_cu = 1;
        if (cus < 256) { fprintf(stderr, "kernel_launch: built for a 256-CU device (got %d)\n", cus); grid_blocks = -1; return; }
        grid_blocks = 256;
    }
    if (grid_blocks < 0) return;
    Params p{};
    p.x = (const float*)d_in[0]; p.c = (const float*)d_in[1]; p.pos = (const int*)d_in[2]; p.ada_w = (const float*)d_in[3]; p.ada_b = (const float*)d_in[4];
    p.ln_g = (const float*)d_in[5]; p.ln_b = (const float*)d_in[6]; p.ev_w_in = (const float*)d_in[7]; p.ev_w_out = (const float*)d_in[8]; p.ev_sink = (const float*)d_in[9];
    p.sg_ln_g = (const float*)d_in[10]; p.sg_ln_b = (const float*)d_in[11]; p.sg_w = (const float*)d_in[12]; p.sg_b = (const float*)d_in[13];
    p.od_w_in = (const float*)d_in[14]; p.conv_w = (const float*)d_in[15]; p.conv_b = (const float*)d_in[16]; p.w_a = (const float*)d_in[17]; p.b_a = (const float*)d_in[18];
    p.w_x = (const float*)d_in[19]; p.b_x = (const float*)d_in[20]; p.lam = (const float*)d_in[21]; p.od_w_out = (const float*)d_in[22];
    p.out = (float*)d_out; p.ws = (unsigned char*)d_ws;
    void* args[] = {&p};
    hipError_t e = hipLaunchCooperativeKernel((const void*)fwd_megakernel, dim3(grid_blocks), dim3(512), args, LDS_BYTES, stream);
    if (e != hipSuccess) fprintf(stderr, "cooperative launch failed: %s (grid %d)\n", hipGetErrorString(e), grid_blocks);
}
```
